# Optimizing an MI355X kernel written in HIP

```python
import math
import jax, jax.numpy as jnp
from jax import lax
import numpy as np

D_MODEL = 2048
BATCH = 1
SEQ = 8192
DEPTH = 2
DEC_BATCH = 2
DEC_SEQ = 16384
PAST_LEN = 128

HEAD_DIM = 128
HEADS_PER_GROUP = 4
DILATED_GROUPS = ((128, 1), (512, 4), (2048, 16))
N_GROUPS = len(DILATED_GROUPS)
N_ATTN_HEADS = N_GROUPS * HEADS_PER_GROUP
D_ATTN = N_ATTN_HEADS * HEAD_DIM
D_ATTN_OUT = HEADS_PER_GROUP * HEAD_DIM
Q_BLOCK = 64
NEG_INF = -1e30
D_RNN = D_MODEL
N_RNN_BLOCKS = 16
RNN_BLOCK = D_RNN // N_RNN_BLOCKS
CONV_WIDTH = 4
CONV_LEFT = 2
LRU_C = 8.0
REL_BUCKETS = 32
REL_MAX_DIST = 1024
ALPHA = (2.0 * DEPTH) ** 0.25
BETA = (8.0 * DEPTH) ** -0.25
LN_EPS = 1e-5
SPLITS = (D_ATTN, 2 * D_ATTN, 3 * D_ATTN, 3 * D_ATTN + D_ATTN_OUT,
          3 * D_ATTN + D_ATTN_OUT + D_RNN, 3 * D_ATTN + D_ATTN_OUT + 2 * D_RNN)
N_IN = 3 * D_ATTN + D_ATTN_OUT + 2 * D_RNN + 2 * D_MODEL

kernel_name = "hybrid_dilated_attn_rglru_encoder"


def t5_bucket(rel):
    nb = REL_BUCKETS // 2
    max_exact = nb // 2
    ret = (rel > 0).astype(np.int32) * nb
    n = np.abs(rel)
    large = max_exact + (np.log(np.maximum(n, max_exact) / max_exact)
                         / np.log(REL_MAX_DIST / max_exact) * (nb - max_exact)).astype(np.int32)
    large = np.minimum(large, nb - 1)
    return (ret + np.where(n < max_exact, n, large)).astype(np.int32)


def layer_norm(x, g, b):
    xf = x.astype(jnp.float32)
    mu = jnp.mean(xf, -1, keepdims=True)
    var = jnp.mean(jnp.square(xf - mu), -1, keepdims=True)
    return ((xf - mu) * lax.rsqrt(var + LN_EPS) * g + b).astype(x.dtype)


def banded_attention(q, k, v, bias_tab, half):
    N, L, H, E = q.shape
    nb = -(-L // Q_BLOCK)
    Lp = nb * Q_BLOCK
    W = Q_BLOCK + 2 * half
    qb = jnp.pad(q, ((0, 0), (0, Lp - L), (0, 0), (0, 0))).reshape(N, nb, Q_BLOCK, H, E)
    pad_kv = ((0, 0), (half, Lp - L + half), (0, 0), (0, 0))
    idx = np.arange(nb)[:, None] * Q_BLOCK + np.arange(W)[None, :]
    kb = jnp.pad(k, pad_kv)[:, idx]
    vb = jnp.pad(v, pad_kv)[:, idx].astype(jnp.float32)
    off = np.arange(W)[None, :] - half - np.arange(Q_BLOCK)[:, None]
    kpos = idx - half
    valid = (np.abs(off) <= half)[None] & ((kpos >= 0) & (kpos < L))[:, None, :]
    bias = jnp.transpose(bias_tab[np.clip(off, -half, half) + half], (2, 0, 1)).astype(jnp.float32)
    s = jnp.einsum('nbqhe,nbkhe->nbhqk', qb, kb, preferred_element_type=jnp.float32) * (E ** -0.5)
    s = jnp.where(valid[None, :, None], s + bias[None, None], NEG_INF)
    m = jnp.max(s, -1, keepdims=True)
    p = jnp.exp(s - m)
    den = jnp.sum(p, -1, keepdims=True)
    o = jnp.einsum('nbhqk,nbkhe->nbqhe', p, vb) / jnp.transpose(den, (0, 1, 3, 2, 4))
    lse = jnp.transpose((m + jnp.log(den))[..., 0], (0, 1, 3, 2))
    return o.reshape(N, Lp, H, E)[:, :L], lse.reshape(N, Lp, H)[:, :L]


def dilated_attention(q, k, v, rel_bias):
    B, S, _, E = q.shape
    outs, lses = [], []
    for g, (window, dil) in enumerate(DILATED_GROUPS):
        half = window // (2 * dil)
        L = S // dil
        hs = slice(g * HEADS_PER_GROUP, (g + 1) * HEADS_PER_GROUP)
        tab = rel_bias[t5_bucket(np.arange(-half, half + 1) * dil)][:, hs]

        def split(t):
            return t[:, :, hs].reshape(B, L, dil, HEADS_PER_GROUP, E).transpose(0, 2, 1, 3, 4) \
                .reshape(B * dil, L, HEADS_PER_GROUP, E)

        o, lse = banded_attention(split(q), split(k), split(v), tab, half)
        outs.append(o.reshape(B, dil, L, HEADS_PER_GROUP, E).transpose(0, 2, 1, 3, 4)
                    .reshape(B, S, HEADS_PER_GROUP, E))
        lses.append(lse.reshape(B, dil, L, HEADS_PER_GROUP).transpose(0, 2, 1, 3)
                    .reshape(B, S, HEADS_PER_GROUP))
    wts = jax.nn.softmax(jnp.stack(lses), axis=0)
    return jnp.sum(wts[..., None] * jnp.stack(outs), axis=0)


def _lin_combine(c1, c2):
    a1, b1 = c1
    a2, b2 = c2
    return a1 * a2, a2 * b1 + b2


def rglru(xc, w_gate, b_gate, lam, reverse):
    B, S, _ = xc.shape
    xb = xc.reshape(B, S, N_RNN_BLOCKS, RNN_BLOCK)
    gates = jax.nn.sigmoid(jnp.einsum('bsnc,gncd->gbsnd', xb, w_gate.astype(jnp.float32))
                           + b_gate.astype(jnp.float32)[:, None, None])
    r = gates[0].reshape(B, S, D_RNN)
    i = gates[1].reshape(B, S, D_RNN)
    log_a = -LRU_C * r * jax.nn.softplus(-lam.astype(jnp.float32))
    a = jnp.exp(log_a)
    b = jnp.sqrt(-jnp.expm1(2.0 * log_a)) * (i * xc)
    _, h = lax.associative_scan(_lin_combine, (a, b), axis=1, reverse=reverse)
    return h


def encoder_layer(x, w_in, b_in, conv_w, conv_b, lru_w, lru_b, lru_lam,
                  w_attn_o, w_rnn_o, w_out, ln_g, ln_b, rel_bias):
    B, S, _ = x.shape
    z = x @ w_in + b_in
    q, k, v, ga, xr, gr, gm = jnp.split(z, SPLITS, axis=-1)
    hshape = (B, S, N_ATTN_HEADS, HEAD_DIM)
    oa = dilated_attention(q.reshape(hshape), k.reshape(hshape), v.reshape(hshape), rel_bias)
    ya = (oa.reshape(B, S, D_ATTN_OUT).astype(x.dtype) * jax.nn.silu(ga)) @ w_attn_o
    xp = jnp.pad(xr, ((0, 0), (CONV_LEFT, CONV_WIDTH - 1 - CONV_LEFT), (0, 0)))
    xc = conv_b + sum(xp[:, j:j + S] * conv_w[j] for j in range(CONV_WIDTH))
    xc = xc.astype(jnp.float32)
    h = rglru(xc, lru_w[0], lru_b[0], lru_lam[0], False) + rglru(xc, lru_w[1], lru_b[1], lru_lam[1], True)
    yr = (h.astype(x.dtype) * jax.nn.silu(gr)) @ w_rnn_o
    g = jax.nn.sigmoid(gm).reshape(B, S, 2, D_MODEL)
    out = (g[:, :, 0] * ya + g[:, :, 1] * yr) @ w_out
    return layer_norm(ALPHA * x + out, ln_g, ln_b)


def setup_inputs(seed: int = 0) -> dict:
    key = jax.random.key(seed)
    ks = jax.random.split(key, 16)
    f32 = jnp.float32
    x_prompt = jax.random.normal(ks[0], (BATCH, SEQ, D_MODEL), f32)
    x_sample = jax.random.normal(ks[1], (DEC_BATCH, DEC_SEQ, D_MODEL), f32)
    w_in = jax.random.normal(ks[2], (DEPTH, D_MODEL, N_IN), f32) * D_MODEL ** -0.5
    w_in = w_in.at[:, :, 2 * D_ATTN:3 * D_ATTN].multiply(BETA)
    b_in = 0.01 * jax.random.normal(ks[3], (DEPTH, N_IN), f32)
    conv_w = jax.random.normal(ks[4], (DEPTH, CONV_WIDTH, D_RNN), f32) * CONV_WIDTH ** -0.5
    conv_b = 0.01 * jax.random.normal(ks[5], (DEPTH, D_RNN), f32)
    lru_w = jax.random.normal(ks[6], (DEPTH, 2, 2, N_RNN_BLOCKS, RNN_BLOCK, RNN_BLOCK), f32) * RNN_BLOCK ** -0.5
    lru_b = 0.01 * jax.random.normal(ks[7], (DEPTH, 2, 2, N_RNN_BLOCKS, RNN_BLOCK), f32)
    a_c = jax.random.uniform(ks[8], (DEPTH, 2, D_RNN), f32, minval=0.9, maxval=0.999)
    s = a_c ** (1.0 / LRU_C)
    lru_lam = jnp.log(s) - jnp.log1p(-s)
    w_attn_o = jax.random.normal(ks[9], (DEPTH, D_ATTN_OUT, D_MODEL), f32) * (D_ATTN_OUT ** -0.5) * BETA
    w_rnn_o = jax.random.normal(ks[10], (DEPTH, D_RNN, D_MODEL), f32) * (D_RNN ** -0.5) * BETA
    w_out = jax.random.normal(ks[11], (DEPTH, D_MODEL, D_MODEL), f32) * (D_MODEL ** -0.5) * BETA
    ln_g = 1.0 + 0.02 * jax.random.normal(ks[12], (DEPTH, D_MODEL), f32)
    ln_b = 0.02 * jax.random.normal(ks[13], (DEPTH, D_MODEL), f32)
    rel_bias = 0.1 * jax.random.normal(ks[14], (REL_BUCKETS, N_ATTN_HEADS), f32)
    return {"x_prompt": x_prompt, "x_sample": x_sample, "w_in": w_in, "b_in": b_in,
            "conv_w": conv_w, "conv_b": conv_b, "lru_w": lru_w, "lru_b": lru_b, "lru_lam": lru_lam,
            "w_attn_o": w_attn_o, "w_rnn_o": w_rnn_o, "w_out": w_out,
            "ln_g": ln_g, "ln_b": ln_b, "rel_bias": rel_bias}


def trunk(x, w_in, b_in, conv_w, conv_b, lru_w, lru_b, lru_lam, w_attn_o, w_rnn_o, w_out, ln_g, ln_b, rel_bias):
    for l in range(DEPTH):
        x = encoder_layer(x, w_in[l], b_in[l], conv_w[l], conv_b[l], lru_w[l], lru_b[l], lru_lam[l],
                          w_attn_o[l], w_rnn_o[l], w_out[l], ln_g[l], ln_b[l], rel_bias)
    return x


def reference(x_prompt, x_sample, w_in, b_in, conv_w, conv_b, lru_w, lru_b, lru_lam,
              w_attn_o, w_rnn_o, w_out, ln_g, ln_b, rel_bias):
    y_prompt = trunk(x_prompt, w_in, b_in, conv_w, conv_b, lru_w, lru_b, lru_lam,
                     w_attn_o, w_rnn_o, w_out, ln_g, ln_b, rel_bias)
    y_sample = trunk(x_sample, w_in, b_in, conv_w, conv_b, lru_w, lru_b, lru_lam,
                     w_attn_o, w_rnn_o, w_out, ln_g, ln_b, rel_bias)
    return (y_prompt, y_sample)
```

```cpp
#include <hip/hip_runtime.h>
#include <hip/hip_cooperative_groups.h>
#include <cstdio>
#include <cstdint>
namespace cg = cooperative_groups;

#define LAS __attribute__((address_space(3)))
typedef unsigned short bf16_t;
typedef short bf16x8 __attribute__((ext_vector_type(8)));
typedef short s16x4 __attribute__((ext_vector_type(4)));
typedef float f32x4 __attribute__((ext_vector_type(4)));
typedef float f32x2 __attribute__((ext_vector_type(2)));
typedef unsigned u32x4 __attribute__((ext_vector_type(4)));
typedef unsigned u32x2 __attribute__((ext_vector_type(2)));

constexpr int DM = 2048, NIN = 13312, NTOK = 40960;
constexpr int C_Q = 0, C_K = 1536, C_V = 3072, C_GA = 4608, C_XR = 5120, C_GR = 7168, C_GM = 9216;
constexpr int C_TA = 1536;
constexpr int C_M = C_XR;
constexpr float ALPHA = 1.4142135623730951f, LN_EPS = 1e-5f;
constexpr float LOG2E = 1.4426950408889634f, LN2 = 0.6931471805599453f;

constexpr size_t MiB = 1u << 20;
constexpr size_t WS_BIAS = 1 * MiB, WS_WIN = 2 * MiB, WS_WA = 106 * MiB, WS_WR = 110 * MiB, WS_WO = 126 * MiB, WS_LW = 142 * MiB,
                 WS_XB = 146 * MiB, WS_Z = 306 * MiB, WS_LSE = 722 * MiB, WS_AGG = 723 * MiB, WS_CARRY = 731 * MiB, WS_END = 735 * MiB;
constexpr int LDS_BYTES = 147456;

__device__ const unsigned char T5B[3][129] = {
{11,11,11,11,11,11,11,11,11,11,11,11,11,11,11,10,10,10,10,10,10,10,10,10,10,10,10,10,10,10,10,10,10,10,10,10,10,10,9,9,9,9,9,9,9,9,9,9,9,9,8,8,8,8,8,8,8,7,6,5,4,3,2,1,0,17,18,19,20,21,22,23,24,24,24,24,24,24,24,25,25,25,25,25,25,25,25,25,25,25,25,26,26,26,26,26,26,26,26,26,26,26,26,26,26,26,26,26,26,26,26,26,26,26,27,27,27,27,27,27,27,27,27,27,27,27,27,27,27},
{13,13,13,13,13,13,13,13,13,13,13,13,13,13,13,13,13,13,13,13,13,13,13,12,12,12,12,12,12,12,12,12,12,12,12,12,12,12,12,12,12,12,11,11,11,11,11,11,11,11,11,11,10,10,10,10,10,10,9,9,9,8,8,4,0,20,24,24,25,25,25,26,26,26,26,26,26,27,27,27,27,27,27,27,27,27,27,28,28,28,28,28,28,28,28,28,28,28,28,28,28,28,28,28,28,28,29,29,29,29,29,29,29,29,29,29,29,29,29,29,29,29,29,29,29,29,29,29,29},
{15,15,15,15,15,15,15,15,15,15,15,15,15,15,15,15,15,15,15,15,15,15,15,15,15,15,15,15,15,15,14,14,14,14,14,14,14,14,14,14,14,14,14,14,14,13,13,13,13,13,13,13,13,13,12,12,12,12,12,11,11,10,10,9,0,25,26,26,27,27,28,28,28,28,28,29,29,29,29,29,29,29,29,29,30,30,30,30,30,30,30,30,30,30,30,30,30,30,30,31,31,31,31,31,31,31,31,31,31,31,31,31,31,31,31,31,31,31,31,31,31,31,31,31,31,31,31,31,31}};

__device__ __forceinline__ unsigned cvt_pk_bf16(float lo, float hi) { unsigned r; asm volatile("v_cvt_pk_bf16_f32 %0, %1, %2" : "=v"(r) : "v"(lo), "v"(hi)); return r; }
__device__ __forceinline__ float bf_lo(unsigned u) { return __uint_as_float(u << 16); }
__device__ __forceinline__ float bf_hi(unsigned u) { return __uint_as_float(u & 0xffff0000u); }
__device__ __forceinline__ float bf1(bf16_t u) { return __uint_as_float(((unsigned)u) << 16); }
__device__ __forceinline__ float sigm(float x) { return __builtin_amdgcn_rcpf(1.0f + __expf(-x)); }
__device__ __forceinline__ float silu(float x) { return x * sigm(x); }

namespace pg8 {
constexpr int BM = 256, BK = 64, HALF = 128, HTB = HALF * BK * 2, STAGE_BYTES = 8 * HTB, NXCD = 8, WGM = 8;
__host__ __device__ __forceinline__ int lds_byte(int r, int c) { const int st = (r >> 4) * 2 + (c >> 5), rr = r & 15, cc = c & 31, ob = rr * 64 + cc * 2; return st * 1024 + (ob ^ (((ob >> 9) & 1) << 5)); }
__host__ __device__ __forceinline__ void stage_rc(int b, int& R, int& C) { const int st = b / 1024, sb = b % 1024, swz = sb ^ (((sb >> 9) & 1) << 5); R = (st >> 1) * 16 + swz / 64; C = (st & 1) * 32 + (swz % 64) / 2; }
__host__ __device__ __forceinline__ int perm32(int rho) { const int n = rho >> 4, i = rho & 15; return 8 * (i >> 2) + 4 * n + (i & 3); }

struct Unit { int pm, pn; };
struct Gemm { const bf16_t* A; const bf16_t* Bt; int M, N, K, lda; };

struct StaticOrder {
    int nM, nN, nwg, G, c;
    __host__ __device__ void init(int M, int N, int G_, int c_) { nM = M / BM; nN = N / BM; nwg = nM * nN; G = G_; c = c_; }
    __host__ __device__ bool next(int i, Unit& u) const {
        const long L = (long)i * G + c; if (L >= nwg) return false;
        int wgid = (int)L; { const int q = nwg / NXCD, r = nwg % NXCD, xcd = wgid % NXCD, off = wgid / NXCD; wgid = (xcd < r ? xcd * (q + 1) : r * (q + 1) + (xcd - r) * q) + off; }
        const int nig = WGM * nN, gid = wgid / nig, fm = gid * WGM, gsz = (nM - fm) < WGM ? (nM - fm) : WGM;
        u.pm = fm + ((wgid % nig) % gsz); u.pn = (wgid % nig) / gsz; return true;
    }
};

struct EpiIn {
    bf16_t* O; int ldc; const float* bias;
    __device__ __forceinline__ void operator()(const f32x4 (&acc)[2][2][4][2], const Unit& u, int wr, int wc, int fr, int fq) const {
        const int row0 = u.pm * BM + wr * 64 + fr; const int col0 = u.pn * BM + wc * 32 + 8 * fq;
        f32x4 bv[2][2];
#pragma unroll
        for (int bj = 0; bj < 2; ++bj)
#pragma unroll
            for (int n = 0; n < 2; ++n) bv[bj][n] = *(const f32x4*)(bias + col0 + bj * HALF + 4 * n);
#pragma unroll
        for (int ai = 0; ai < 2; ++ai)
#pragma unroll
            for (int m = 0; m < 4; ++m) { bf16_t* rowp = O + (size_t)(row0 + ai * HALF + m * 16) * ldc + col0;
#pragma unroll
                for (int bj = 0; bj < 2; ++bj) { const f32x4 v0 = acc[ai][bj][m][0] + bv[bj][0], v1 = acc[ai][bj][m][1] + bv[bj][1];
                    u32x4 w; w.x = cvt_pk_bf16(v0[0], v0[1]); w.y = cvt_pk_bf16(v0[2], v0[3]); w.z = cvt_pk_bf16(v1[0], v1[1]); w.w = cvt_pk_bf16(v1[2], v1[3]);
                    *(u32x4*)(rowp + bj * HALF) = w; } }
    }
};
struct EpiGateA {
    bf16_t* Z;
    __device__ __forceinline__ void operator()(const f32x4 (&acc)[2][2][4][2], const Unit& u, int wr, int wc, int fr, int fq) const {
        const int row0 = u.pm * BM + wr * 64 + fr; const int col0 = u.pn * BM + wc * 32 + 8 * fq;
#pragma unroll
        for (int ai = 0; ai < 2; ++ai)
#pragma unroll
            for (int m = 0; m < 4; ++m) { bf16_t* zr = Z + (size_t)(row0 + ai * HALF + m * 16) * NIN + col0;
#pragma unroll
                for (int bj = 0; bj < 2; ++bj) { const f32x4 v0 = acc[ai][bj][m][0], v1 = acc[ai][bj][m][1];
                    const u32x4 g = *(const u32x4*)(zr + C_GM + bj * HALF);
                    u32x4 w; w.x = cvt_pk_bf16(v0[0] * sigm(bf_lo(g.x)), v0[1] * sigm(bf_hi(g.x))); w.y = cvt_pk_bf16(v0[2] * sigm(bf_lo(g.y)), v0[3] * sigm(bf_hi(g.y)));
                    w.z = cvt_pk_bf16(v1[0] * sigm(bf_lo(g.z)), v1[1] * sigm(bf_hi(g.z))); w.w = cvt_pk_bf16(v1[2] * sigm(bf_lo(g.w)), v1[3] * sigm(bf_hi(g.w)));
                    *(u32x4*)(zr + C_TA + bj * HALF) = w; } }
    }
};
struct EpiGateR {
    bf16_t* Z;
    __device__ __forceinline__ void operator()(const f32x4 (&acc)[2][2][4][2], const Unit& u, int wr, int wc, int fr, int fq) const {
        const int row0 = u.pm * BM + wr * 64 + fr; const int col0 = u.pn * BM + wc * 32 + 8 * fq;
#pragma unroll
        for (int ai = 0; ai < 2; ++ai)
#pragma unroll
            for (int m = 0; m < 4; ++m) { bf16_t* zr = Z + (size_t)(row0 + ai * HALF + m * 16) * NIN + col0;
#pragma unroll
                for (int bj = 0; bj < 2; ++bj) { const f32x4 v0 = acc[ai][bj][m][0], v1 = acc[ai][bj][m][1];
                    const u32x4 g = *(const u32x4*)(zr + C_GM + DM + bj * HALF);
                    const u32x4 t = *(const u32x4*)(zr + C_TA + bj * HALF);
                    u32x4 w; w.x = cvt_pk_bf16(bf_lo(t.x) + v0[0] * sigm(bf_lo(g.x)), bf_hi(t.x) + v0[1] * sigm(bf_hi(g.x)));
                    w.y = cvt_pk_bf16(bf_lo(t.y) + v0[2] * sigm(bf_lo(g.y)), bf_hi(t.y) + v0[3] * sigm(bf_hi(g.y)));
                    w.z = cvt_pk_bf16(bf_lo(t.z) + v1[0] * sigm(bf_lo(g.z)), bf_hi(t.z) + v1[1] * sigm(bf_hi(g.z)));
                    w.w = cvt_pk_bf16(bf_lo(t.w) + v1[2] * sigm(bf_lo(g.w)), bf_hi(t.w) + v1[3] * sigm(bf_hi(g.w)));
                    *(u32x4*)(zr + C_M + bj * HALF) = w; } }
    }
};
struct EpiRes {
    const float* xin; float* out;
    __device__ __forceinline__ void operator()(const f32x4 (&acc)[2][2][4][2], const Unit& u, int wr, int wc, int fr, int fq) const {
        const int row0 = u.pm * BM + wr * 64 + fr; const int col0 = u.pn * BM + wc * 32 + 8 * fq;
#pragma unroll
        for (int ai = 0; ai < 2; ++ai)
#pragma unroll
            for (int m = 0; m < 4; ++m) { const size_t off = (size_t)(row0 + ai * HALF + m * 16) * DM + col0;
#pragma unroll
                for (int bj = 0; bj < 2; ++bj) {
                    const f32x4 x0 = *(const f32x4*)(xin + off + bj * HALF), x1 = *(const f32x4*)(xin + off + bj * HALF + 4);
                    const f32x4 o0 = x0 * ALPHA + acc[ai][bj][m][0], o1 = x1 * ALPHA + acc[ai][bj][m][1];
                    *(f32x4*)(out + off + bj * HALF) = o0; *(f32x4*)(out + off + bj * HALF + 4) = o1; } }
    }
};

template <class Epi>
__device__ __forceinline__ void gemm_phase(LAS unsigned char* lds, const Gemm g, const StaticOrder& S, const Epi& E) {
    int tid = threadIdx.x; asm volatile("" : "+v"(tid));
    const int wid = __builtin_amdgcn_readfirstlane(tid >> 6), lane = tid & 63, wr = wid >> 2, wc = wid & 3, fr = lane & 15, fq = lane >> 4;
    const int K = g.K, nt = K / BK, lda = g.lda;
    unsigned voffA[2], voffB[2];
#pragma unroll
    for (int i = 0; i < 2; ++i) { int R, C; stage_rc(tid * 16 + i * 8192, R, C); const int Rb = (R & ~31) + perm32(R & 31);
        voffA[i] = (unsigned)(R * lda + C) * 2u; voffB[i] = (unsigned)(Rb * K + C) * 2u; }
    const size_t kstep = (size_t)(BK * 2);
    const size_t hstepA = (size_t)HALF * lda * 2, hstepB = (size_t)HALF * K * 2;
    const size_t tstepA = 2 * hstepA, tstepB = 2 * hstepB;
    const unsigned ldsw = (unsigned)wid * 1024u;
    const int aoff = lds_byte(wr * 64 + fr, fq * 8), boff = lds_byte(wc * 32 + fr, fq * 8);
#define PG8_SA(b, h) (((b) * 2 + (h)) * HTB)
#define PG8_SB(b, h) ((4 + (b) * 2 + (h)) * HTB)
#define PG8_STAGE(bufoff, gbase, voff) do { _Pragma("unroll") for (int _i = 0; _i < 2; ++_i) \
        __builtin_amdgcn_global_load_lds((const unsigned*)((const char*)(gbase) + (voff)[_i]), (LAS unsigned*)(lds + (bufoff) + ldsw + _i * 8192), 16, 0, 0); } while (0)
#define PG8_LDA(dst, b, h) do { _Pragma("unroll") for (int m = 0; m < 4; ++m) _Pragma("unroll") for (int k = 0; k < 2; ++k) dst[m][k] = *(const LAS bf16x8*)(lds + PG8_SA(b, h) + aoff + m * 2048 + k * 1024); } while (0)
#define PG8_LDB(dst, b, h) do { _Pragma("unroll") for (int n = 0; n < 2; ++n) _Pragma("unroll") for (int k = 0; k < 2; ++k) dst[n][k] = *(const LAS bf16x8*)(lds + PG8_SB(b, h) + boff + n * 2048 + k * 1024); } while (0)
#define PG8_MMA(ai, bj, At, Bt) do { __builtin_amdgcn_s_setprio(1); _Pragma("unroll") for (int m = 0; m < 4; ++m) _Pragma("unroll") for (int n = 0; n < 2; ++n) _Pragma("unroll") for (int k = 0; k < 2; ++k) \
        acc[ai][bj][m][n] = __builtin_amdgcn_mfma_f32_16x16x32_bf16(Bt[n][k], At[m][k], acc[ai][bj][m][n], 0, 0, 0); __builtin_amdgcn_s_setprio(0); } while (0)
#define PG8_WAIT_V(n) asm volatile("s_waitcnt vmcnt(" #n ")" ::: "memory")
#define PG8_WAIT_L(n) asm volatile("s_waitcnt lgkmcnt(" #n ")" ::: "memory")
#define PG8_BAR __builtin_amdgcn_s_barrier()
#define PG8_SCHED __builtin_amdgcn_sched_barrier(0)
    Unit cur, nxt; int ui = 0;
    if (!S.next(0, cur)) return;
    f32x4 acc[2][2][4][2];
#pragma unroll
    for (int a = 0; a < 2; ++a)
#pragma unroll
        for (int b = 0; b < 2; ++b)
#pragma unroll
            for (int m = 0; m < 4; ++m)
#pragma unroll
                for (int n = 0; n < 2; ++n) acc[a][b][m][n] = (f32x4){0.f, 0.f, 0.f, 0.f};
    bf16x8 At[4][2], B0[2][2], B1[2][2];
    const char* cA = (const char*)g.A + (size_t)cur.pm * tstepA; const char* cB = (const char*)g.Bt + (size_t)cur.pn * tstepB;
    PG8_STAGE(PG8_SB(0, 0), cB, voffB); PG8_STAGE(PG8_SB(0, 1), cB + hstepB, voffB); PG8_STAGE(PG8_SA(0, 0), cA, voffA); PG8_STAGE(PG8_SA(0, 1), cA + hstepA, voffA);
    if (wr == 1) PG8_BAR;
    PG8_WAIT_V(2); PG8_BAR;
    PG8_STAGE(PG8_SB(1, 0), cB + kstep, voffB); PG8_STAGE(PG8_SA(1, 0), cA + kstep, voffA); PG8_STAGE(PG8_SB(1, 1), cB + hstepB + kstep, voffB);
    PG8_WAIT_V(6); PG8_BAR;
    for (;;) {
        const bool has_next = S.next(ui + 1, nxt);
        const char* nA = has_next ? (const char*)g.A + (size_t)nxt.pm * tstepA : cA; const char* nB = has_next ? (const char*)g.Bt + (size_t)nxt.pn * tstepB : cB;
        for (int t = 0; t < nt; t += 2) {
            const bool last = (t == nt - 2);
            const char* a1 = cA + (size_t)(t + 1) * kstep;
            const char* a2 = last ? nA : cA + (size_t)(t + 2) * kstep; const char* b2 = last ? nB : cB + (size_t)(t + 2) * kstep;
            const char* a3 = a2 + kstep; const char* b3 = b2 + kstep;
            PG8_LDB(B0, 0, 0); PG8_LDB(B1, 0, 1); PG8_SCHED; PG8_LDA(At, 0, 0); PG8_STAGE(PG8_SA(1, 1), a1 + hstepA, voffA);
            PG8_WAIT_V(8); PG8_WAIT_L(0); PG8_BAR; PG8_MMA(0, 0, At, B0); PG8_MMA(0, 1, At, B1); PG8_BAR; PG8_SCHED;
            PG8_LDA(At, 0, 1); PG8_STAGE(PG8_SB(0, 0), b2, voffB); PG8_STAGE(PG8_SB(0, 1), b2 + hstepB, voffB); PG8_STAGE(PG8_SA(0, 0), a2, voffA);
            PG8_WAIT_V(8); PG8_WAIT_L(0); PG8_BAR; PG8_MMA(1, 0, At, B0); PG8_MMA(1, 1, At, B1); PG8_BAR; PG8_SCHED;
            PG8_LDB(B0, 1, 0); PG8_LDB(B1, 1, 1); PG8_SCHED; PG8_LDA(At, 1, 0); PG8_STAGE(PG8_SA(0, 1), a2 + hstepA, voffA);
            PG8_WAIT_V(8); PG8_WAIT_L(0); PG8_BAR; PG8_MMA(0, 0, At, B0); PG8_MMA(0, 1, At, B1); PG8_BAR; PG8_SCHED;
            PG8_LDA(At, 1, 1); PG8_STAGE(PG8_SB(1, 0), b3, voffB); PG8_STAGE(PG8_SB(1, 1), b3 + hstepB, voffB); PG8_STAGE(PG8_SA(1, 0), a3, voffA);
            PG8_WAIT_V(8); PG8_WAIT_L(0); PG8_BAR; PG8_MMA(1, 0, At, B0); PG8_MMA(1, 1, At, B1); PG8_BAR; PG8_SCHED;
        }
        if (wr == 0) PG8_BAR;
        E(acc, cur, wr, wc, fr, fq);
        if (!has_next) break;
#pragma unroll
        for (int a = 0; a < 2; ++a)
#pragma unroll
            for (int b = 0; b < 2; ++b)
#pragma unroll
                for (int m = 0; m < 4; ++m)
#pragma unroll
                    for (int n = 0; n < 2; ++n) acc[a][b][m][n] = (f32x4){0.f, 0.f, 0.f, 0.f};
        cur = nxt; cA = nA; cB = nB; ++ui;
        if (wr == 1) PG8_BAR;
    }
    PG8_WAIT_V(0);
    PG8_BAR;
#undef PG8_SA
#undef PG8_SB
#undef PG8_STAGE
#undef PG8_LDA
#undef PG8_LDB
#undef PG8_MMA
#undef PG8_WAIT_V
#undef PG8_WAIT_L
#undef PG8_BAR
#undef PG8_SCHED
}
}

__device__ __forceinline__ unsigned f2bf(float f) { unsigned u = __builtin_bit_cast(unsigned, f); return (u + 0x7fffu + ((u >> 16) & 1u)) >> 16; }
__device__ __forceinline__ unsigned pk2(float lo, float hi) { return f2bf(lo) | (f2bf(hi) << 16); }
__device__ __forceinline__ void p0_transpose_item(const float* W, int K, int N, bf16_t* WT, LAS float* scr, int item, int lane) {
    const int nblk = N / 32, kb = item / nblk, nb = item % nblk, k0 = 64 * kb, n0 = 32 * nb;
#pragma unroll 8
    for (int i = 0; i < 32; ++i) { const int kk = 2 * i + (lane >> 5); scr[kk * 33 + (lane & 31)] = W[(size_t)(k0 + kk) * N + n0 + (lane & 31)]; }
    asm volatile("s_waitcnt lgkmcnt(0)" ::: "memory");
    const int c = lane & 7;
#pragma unroll
    for (int j = 0; j < 4; ++j) { const int n = (lane >> 3) + 8 * j; const LAS float* s = scr + (8 * c) * 33 + n;
        u32x4 o; o.x = pk2(s[0 * 33], s[1 * 33]); o.y = pk2(s[2 * 33], s[3 * 33]); o.z = pk2(s[4 * 33], s[5 * 33]); o.w = pk2(s[6 * 33], s[7 * 33]);
        *(u32x4*)(WT + (size_t)(n0 + n) * K + k0 + 8 * c) = o; }
    asm volatile("s_waitcnt lgkmcnt(0)" ::: "memory");
}

constexpr int KVS = 272;
constexpr int LDS_K = 0, LDS_V = 256 * KVS, LDS_SB = 2 * 256 * KVS;
__device__ __forceinline__ void attn_phase(LAS unsigned char* lds, bf16_t* Z, int S, float* lse, const float* biasTab, int bid, int G) {
    int tid = threadIdx.x; asm volatile("" : "+v"(tid));
    const int lane = tid & 63, w = __builtin_amdgcn_readfirstlane(tid >> 6), l15 = lane & 15, quad = lane >> 4;
    const int nunits = 12 * (S >> 7);
    for (int u = bid; u < nunits; u += G) {
        const int hd = u % 12, rest = u / 12, g = hd >> 2, dsh = 2 * g;
        const int Lsub = S >> dsh, cpr = Lsub >> 7, r = rest / cpr, jc = rest - r * cpr, j0 = jc << 7;
        {
            const int c = tid & 15, rbase = tid >> 4;
            u32x4 kk[8], vv[8];
#pragma unroll
            for (int it = 0; it < 8; ++it) { const int i = rbase + 32 * it, j = j0 - 64 + i; const bool ok = (j >= 0) && (j < Lsub);
                const int jcl = ok ? j : 0; const bf16_t* p = Z + ((size_t)((jcl << dsh) + r)) * NIN + hd * 128 + c * 8;
                u32x4 a = *(const u32x4*)(p + C_K), b = *(const u32x4*)(p + C_V);
                if (!ok) { a = (u32x4){0u, 0u, 0u, 0u}; b = a; }
                kk[it] = a; vv[it] = b; }
#pragma unroll
            for (int it = 0; it < 8; ++it) { const int i = rbase + 32 * it;
                *(LAS u32x4*)(lds + LDS_K + i * KVS + c * 16) = kk[it]; *(LAS u32x4*)(lds + LDS_V + i * KVS + c * 16) = vv[it]; }
            if (tid < 129) ((LAS float*)(lds + LDS_SB))[tid] = biasTab[hd * 129 + tid];
        }
        const int jq = j0 + 16 * w + l15; const size_t tokq = ((size_t)jq << dsh) + r;
        bf16_t* qrow = Z + tokq * NIN + hd * 128;
        bf16x8 qf[4];
#pragma unroll
        for (int ks = 0; ks < 4; ++ks) qf[ks] = *(const bf16x8*)(qrow + ks * 32 + quad * 8);
        __syncthreads();
        f32x4 sacc[9];
        const LAS unsigned char* kbase = lds + LDS_K + (16 * w + l15) * KVS + quad * 16;
#pragma unroll
        for (int kt = 0; kt < 9; ++kt) { f32x4 a4 = (f32x4){0.f, 0.f, 0.f, 0.f};
#pragma unroll
            for (int ks = 0; ks < 4; ++ks) { const bf16x8 a = *(const LAS bf16x8*)(kbase + kt * 16 * KVS + ks * 64); a4 = __builtin_amdgcn_mfma_f32_16x16x32_bf16(a, qf[ks], a4, 0, 0, 0); }
            sacc[kt] = a4; }
        const float sc = 0.08838834764831845f * LOG2E;
        const LAS float* sb = (const LAS float*)(lds + LDS_SB);
        float mx = -1e30f;
#pragma unroll
        for (int kt = 0; kt < 9; ++kt)
#pragma unroll
            for (int i = 0; i < 4; ++i) { const int c = 16 * kt + 4 * quad + i, o64 = c - l15, jk = j0 + 16 * w - 64 + c;
                const bool valid = (o64 >= 0) && (o64 <= 128) && (jk >= 0) && (jk < Lsub);
                const int oc = o64 < 0 ? 0 : (o64 > 128 ? 128 : o64);
                const float s = valid ? (sacc[kt][i] * sc + sb[oc]) : -1e30f;
                sacc[kt][i] = s; mx = fmaxf(mx, s); }
        mx = fmaxf(mx, __shfl_xor(mx, 16)); mx = fmaxf(mx, __shfl_xor(mx, 32));
        float den = 0.f;
#pragma unroll
        for (int kt = 0; kt < 9; ++kt)
#pragma unroll
            for (int i = 0; i < 4; ++i) { const float p = __builtin_amdgcn_exp2f(sacc[kt][i] - mx); sacc[kt][i] = p; den += p; }
        den += __shfl_xor(den, 16); den += __shfl_xor(den, 32);
        bf16x8 pb[5];
#pragma unroll
        for (int s = 0; s < 5; ++s) { const f32x4 lo = sacc[2 * s]; const f32x4 hi = (2 * s + 1 < 9) ? sacc[(2 * s + 1 < 9) ? 2 * s + 1 : 8] : (f32x4){0.f, 0.f, 0.f, 0.f};
            u32x4 pk; pk.x = cvt_pk_bf16(lo[0], lo[1]); pk.y = cvt_pk_bf16(lo[2], lo[3]); pk.z = cvt_pk_bf16(hi[0], hi[1]); pk.w = cvt_pk_bf16(hi[2], hi[3]);
            pb[s] = __builtin_bit_cast(bf16x8, pk); }
        f32x4 oacc[8];
        const LAS unsigned char* vbase = lds + LDS_V + (16 * w + 4 * quad + (l15 >> 2)) * KVS + (l15 & 3) * 8;
#pragma unroll
        for (int dt = 0; dt < 8; ++dt) { f32x4 o4 = (f32x4){0.f, 0.f, 0.f, 0.f};
#pragma unroll
            for (int s = 0; s < 5; ++s) {
                const s16x4 lo = __builtin_bit_cast(s16x4, __builtin_amdgcn_ds_read_tr16_b64_v4i16((LAS s16x4*)(vbase + (s * 32) * KVS + dt * 32)));
                s16x4 hi = (s16x4){0, 0, 0, 0};
                if (s < 4) hi = __builtin_bit_cast(s16x4, __builtin_amdgcn_ds_read_tr16_b64_v4i16((LAS s16x4*)(vbase + (s * 32 + 16) * KVS + dt * 32)));
                const bf16x8 a = (bf16x8){lo[0], lo[1], lo[2], lo[3], hi[0], hi[1], hi[2], hi[3]};
                o4 = __builtin_amdgcn_mfma_f32_16x16x32_bf16(a, pb[s], o4, 0, 0, 0); }
            oacc[dt] = o4; }
        const float inv = 1.0f / den;
#pragma unroll
        for (int dt = 0; dt < 8; ++dt) { u32x2 o2; o2.x = cvt_pk_bf16(oacc[dt][0] * inv, oacc[dt][1] * inv); o2.y = cvt_pk_bf16(oacc[dt][2] * inv, oacc[dt][3] * inv);
            *(u32x2*)(qrow + 16 * dt + 4 * quad) = o2; }
        if (quad == 0) lse[tokq * 12 + hd] = (mx + __log2f(den)) * LN2;
        __syncthreads();
    }
}

__device__ __forceinline__ void combine_phase(bf16_t* Z, int S, const float* lse, int bid, int G) {
    int tid = threadIdx.x; asm volatile("" : "+v"(tid));
    const int lane = tid & 63, gw = bid * 8 + (tid >> 6), NGW = G * 8;
    const int h = lane >> 4, dc = lane & 15;
    for (int row = gw; row < S; row += NGW) {
        bf16_t* zr = Z + (size_t)row * NIN;
        const float l0 = lse[(size_t)row * 12 + h], l1 = lse[(size_t)row * 12 + 4 + h], l2 = lse[(size_t)row * 12 + 8 + h];
        const float m = fmaxf(l0, fmaxf(l1, l2));
        float e0 = __expf(l0 - m), e1 = __expf(l1 - m), e2 = __expf(l2 - m); const float inv = 1.0f / (e0 + e1 + e2); e0 *= inv; e1 *= inv; e2 *= inv;
        const u32x4 a = *(const u32x4*)(zr + (0 + h) * 128 + dc * 8), b = *(const u32x4*)(zr + (4 + h) * 128 + dc * 8), c = *(const u32x4*)(zr + (8 + h) * 128 + dc * 8);
        const u32x4 ga = *(const u32x4*)(zr + C_GA + h * 128 + dc * 8);
        u32x4 o;
#define CMB(f) o.f = cvt_pk_bf16((e0 * bf_lo(a.f) + e1 * bf_lo(b.f) + e2 * bf_lo(c.f)) * silu(bf_lo(ga.f)), (e0 * bf_hi(a.f) + e1 * bf_hi(b.f) + e2 * bf_hi(c.f)) * silu(bf_hi(ga.f)))
        CMB(x); CMB(y); CMB(z); CMB(w);
#undef CMB
        *(u32x4*)(zr + C_GA + h * 128 + dc * 8) = o;
    }
}

constexpr int XCF_STRIDE = 132, LDS_XCF = 0, LDS_XCB = 64 * XCF_STRIDE * 4;
template <int PASS>
__device__ __forceinline__ void lru_phase(LAS unsigned char* lds, bf16_t* Z, int S, const float* convw, const float* convb, const bf16_t* LWt, const float* lrub, const float* lam,
                                          f32x2* __restrict__ AGG, const float* __restrict__ CARRY, int bid, int G) {
    int tid = threadIdx.x; asm volatile("" : "+v"(tid));
    const int lane = tid & 63, w = __builtin_amdgcn_readfirstlane(tid >> 6), l15 = lane & 15, quad = lane >> 4;
    LAS float* xcf = (LAS float*)(lds + LDS_XCF);
    const int nunits = (S >> 6) * 16;
    for (int u = bid; u < nunits; u += G) {
        const int n = u & 15, c = u >> 4, t0 = c * 64;
#pragma unroll
        for (int k = 0; k < 2; ++k) { const int item = tid + 512 * k, tt = item >> 4, cc = item & 15, ch0 = n * 128 + cc * 8;
            f32x4 x0 = *(const f32x4*)(convb + ch0), x1 = *(const f32x4*)(convb + ch0 + 4);
#pragma unroll
            for (int j = 0; j < 4; ++j) { const int row = t0 + tt + j - 2;
                if (row >= 0 && row < S) { const u32x4 x = *(const u32x4*)(Z + (size_t)row * NIN + C_XR + ch0);
                    const f32x4 w0 = *(const f32x4*)(convw + j * DM + ch0), w1 = *(const f32x4*)(convw + j * DM + ch0 + 4);
                    x0[0] += bf_lo(x.x) * w0[0]; x0[1] += bf_hi(x.x) * w0[1]; x0[2] += bf_lo(x.y) * w0[2]; x0[3] += bf_hi(x.y) * w0[3];
                    x1[0] += bf_lo(x.z) * w1[0]; x1[1] += bf_hi(x.z) * w1[1]; x1[2] += bf_lo(x.w) * w1[2]; x1[3] += bf_hi(x.w) * w1[3]; } }
            *(LAS f32x4*)(xcf + tt * XCF_STRIDE + cc * 8) = x0; *(LAS f32x4*)(xcf + tt * XCF_STRIDE + cc * 8 + 4) = x1;
            u32x4 pk; pk.x = cvt_pk_bf16(x0[0], x0[1]); pk.y = cvt_pk_bf16(x0[2], x0[3]); pk.z = cvt_pk_bf16(x1[0], x1[1]); pk.w = cvt_pk_bf16(x1[2], x1[3]);
            *(LAS u32x4*)(lds + LDS_XCB + tt * KVS + cc * 16) = pk; }
        __syncthreads();
        const int chl = 16 * w + l15, ch = n * 128 + chl;
        float hsum[4][4];
#pragma unroll
        for (int dir = 0; dir < 2; ++dir) {
            bf16x8 bw[2][4];
#pragma unroll
            for (int gt = 0; gt < 2; ++gt)
#pragma unroll
                for (int ks = 0; ks < 4; ++ks) bw[gt][ks] = *(const bf16x8*)(LWt + ((size_t)(((dir * 2 + gt) * 16 + n) * 128 + chl)) * 128 + ks * 32 + quad * 8);
            f32x4 ga[2][4];
#pragma unroll
            for (int mt = 0; mt < 4; ++mt) { ga[0][mt] = (f32x4){0.f, 0.f, 0.f, 0.f}; ga[1][mt] = (f32x4){0.f, 0.f, 0.f, 0.f};
#pragma unroll
                for (int ks = 0; ks < 4; ++ks) { const bf16x8 a = *(const LAS bf16x8*)(lds + LDS_XCB + (16 * mt + l15) * KVS + ks * 64 + quad * 16);
                    ga[0][mt] = __builtin_amdgcn_mfma_f32_16x16x32_bf16(a, bw[0][ks], ga[0][mt], 0, 0, 0);
                    ga[1][mt] = __builtin_amdgcn_mfma_f32_16x16x32_bf16(a, bw[1][ks], ga[1][mt], 0, 0, 0); } }
            const float br = lrub[((dir * 2 + 0) * 16 + n) * 128 + chl], bi = lrub[((dir * 2 + 1) * 16 + n) * 128 + chl];
            const float lamv = lam[dir * DM + ch]; const float k8 = -8.0f * log1pf(__expf(-lamv));
            float av[4][4], bv[4][4];
#pragma unroll
            for (int mt = 0; mt < 4; ++mt)
#pragma unroll
                for (int i = 0; i < 4; ++i) { const float rg = sigm(ga[0][mt][i] + br), ig = sigm(ga[1][mt][i] + bi); const float la = k8 * rg;
                    const float xcv = xcf[(16 * mt + 4 * quad + i) * XCF_STRIDE + chl];
                    av[mt][i] = __expf(la); bv[mt][i] = sqrtf(fmaxf(-expm1f(2.0f * la), 0.f)) * ig * xcv; }
            float H = 0.f, Ptot = 1.f;
            if (PASS == 1) H = CARRY[(size_t)(c * 2 + dir) * DM + ch];
            if (dir == 0) {
#pragma unroll
                for (int mt = 0; mt < 4; ++mt) {
                    float As = av[mt][0] * av[mt][1] * av[mt][2] * av[mt][3];
                    float Bs = ((bv[mt][0] * av[mt][1] + bv[mt][1]) * av[mt][2] + bv[mt][2]) * av[mt][3] + bv[mt][3];
                    float Ap = __shfl_up(As, 16), Bp = __shfl_up(Bs, 16); if (quad >= 1) { Bs = As * Bp + Bs; As = Ap * As; }
                    Ap = __shfl_up(As, 32); Bp = __shfl_up(Bs, 32); if (quad >= 2) { Bs = As * Bp + Bs; As = Ap * As; }
                    float Ae = __shfl_up(As, 16), Be = __shfl_up(Bs, 16); if (quad == 0) { Ae = 1.f; Be = 0.f; }
                    const float At = __shfl(As, 48 + l15), Bt = __shfl(Bs, 48 + l15);
                    float h = Ae * H + Be; H = At * H + Bt; Ptot *= At;
#pragma unroll
                    for (int i = 0; i < 4; ++i) { h = av[mt][i] * h + bv[mt][i]; hsum[mt][i] = h; }
                }
            } else {
#pragma unroll
                for (int mt = 3; mt >= 0; --mt) {
                    float As = av[mt][3] * av[mt][2] * av[mt][1] * av[mt][0];
                    float Bs = ((bv[mt][3] * av[mt][2] + bv[mt][2]) * av[mt][1] + bv[mt][1]) * av[mt][0] + bv[mt][0];
                    float Ap = __shfl_down(As, 16), Bp = __shfl_down(Bs, 16); if (quad <= 2) { Bs = As * Bp + Bs; As = Ap * As; }
                    Ap = __shfl_down(As, 32); Bp = __shfl_down(Bs, 32); if (quad <= 1) { Bs = As * Bp + Bs; As = Ap * As; }
                    float Ae = __shfl_down(As, 16), Be = __shfl_down(Bs, 16); if (quad == 3) { Ae = 1.f; Be = 0.f; }
                    const float At = __shfl(As, l15), Bt = __shfl(Bs, l15);
                    float h = Ae * H + Be; H = At * H + Bt; Ptot *= At;
#pragma unroll
                    for (int i = 3; i >= 0; --i) { h = av[mt][i] * h + bv[mt][i]; hsum[mt][i] += h; }
                }
            }
            if (PASS == 0) { if (quad == 0) AGG[(size_t)(c * 2 + dir) * DM + ch] = (f32x2){Ptot, H}; }
        }
        if (PASS == 1) {
#pragma unroll
            for (int mt = 0; mt < 4; ++mt)
#pragma unroll
                for (int i = 0; i < 4; ++i) { bf16_t* p = Z + (size_t)(t0 + 16 * mt + 4 * quad + i) * NIN + C_GR + ch;
                    const float grv = bf1(*p); *p = (bf16_t)f2bf(hsum[mt][i] * silu(grv)); }
        }
        __syncthreads();
    }
}

__device__ __forceinline__ void carry_phase(const f32x2* __restrict__ AGG, float* __restrict__ CARRY, int S, int bid, int G) {
    int tid = threadIdx.x; asm volatile("" : "+v"(tid)); const int NC = S >> 6;
    if (tid >= 64) return;
    const int gt = bid * 64 + tid, GT = G * 64;
    for (int chain = gt; chain < 2 * DM; chain += GT) {
        const int dir = chain >> 11, ch = chain & (DM - 1);
        float h = 0.f;
        if (dir == 0) {
#pragma unroll 16
            for (int c = 0; c < NC; ++c) { const f32x2 ab = AGG[(size_t)(c * 2) * DM + ch]; CARRY[(size_t)(c * 2) * DM + ch] = h; h = ab.x * h + ab.y; }
        } else {
#pragma unroll 16
            for (int c = NC - 1; c >= 0; --c) { const f32x2 ab = AGG[(size_t)(c * 2 + 1) * DM + ch]; CARRY[(size_t)(c * 2 + 1) * DM + ch] = h; h = ab.x * h + ab.y; }
        }
    }
}

__device__ __forceinline__ void ln_phase(float* io, bf16_t* xb, int S, const float* lng, const float* lnb, int bid, int G) {
    int tid = threadIdx.x; asm volatile("" : "+v"(tid));
    const int lane = tid & 63, gw = bid * 8 + (tid >> 6), NGW = G * 8;
    f32x4 gv[8], bv[8];
#pragma unroll
    for (int j = 0; j < 8; ++j) { gv[j] = ((const f32x4*)lng)[lane + 64 * j]; bv[j] = ((const f32x4*)lnb)[lane + 64 * j]; }
    for (int row = gw; row < S; row += NGW) {
        f32x4* p = (f32x4*)(io + (size_t)row * DM);
        f32x4 v[8]; float s = 0.f;
#pragma unroll
        for (int j = 0; j < 8; ++j) { v[j] = p[lane + 64 * j]; s += (v[j][0] + v[j][1]) + (v[j][2] + v[j][3]); }
#pragma unroll
        for (int o = 1; o < 64; o <<= 1) s += __shfl_xor(s, o);
        const float mean = s * (1.0f / DM); float q = 0.f;
#pragma unroll
        for (int j = 0; j < 8; ++j) { v[j] = v[j] - mean; q += (v[j][0] * v[j][0] + v[j][1] * v[j][1]) + (v[j][2] * v[j][2] + v[j][3] * v[j][3]); }
#pragma unroll
        for (int o = 1; o < 64; o <<= 1) q += __shfl_xor(q, o);
        const float rstd = 1.0f / sqrtf(q * (1.0f / DM) + LN_EPS);
#pragma unroll
        for (int j = 0; j < 8; ++j) { const f32x4 y = v[j] * rstd * gv[j] + bv[j]; p[lane + 64 * j] = y;
            if (xb) { u32x2 o2; o2.x = cvt_pk_bf16(y[0], y[1]); o2.y = cvt_pk_bf16(y[2], y[3]); ((u32x2*)(xb + (size_t)row * DM))[lane + 64 * j] = o2; } }
    }
}

struct Args { const float* in[15]; float* out; unsigned char* ws; };

__global__ void __launch_bounds__(512, 2) fwd_kernel(Args a) {
    extern __shared__ __attribute__((aligned(16))) unsigned char lds_raw[];
    LAS unsigned char* lds = (LAS unsigned char*)lds_raw;
    cg::grid_group grid = cg::this_grid();
    const int tid = threadIdx.x, lane = tid & 63, wave = __builtin_amdgcn_readfirstlane(tid >> 6);
    const int G = gridDim.x, bid = blockIdx.x;
    const int gw = bid * 8 + wave, NGW = G * 8;
    unsigned char* ws = a.ws;
    float* biasTab = (float*)(ws + WS_BIAS);
    bf16_t* WIN = (bf16_t*)(ws + WS_WIN); bf16_t* WA = (bf16_t*)(ws + WS_WA); bf16_t* WR = (bf16_t*)(ws + WS_WR); bf16_t* WO = (bf16_t*)(ws + WS_WO); bf16_t* LW = (bf16_t*)(ws + WS_LW);
    bf16_t* XB = (bf16_t*)(ws + WS_XB); bf16_t* Z = (bf16_t*)(ws + WS_Z);
    float* LSE = (float*)(ws + WS_LSE); f32x2* AGG = (f32x2*)(ws + WS_AGG); float* CARRY = (float*)(ws + WS_CARRY);

    {
        LAS float* scr = (LAS float*)(lds + wave * 16384);
        constexpr int I_IN = (DM / 64) * (NIN / 32), I_A = (512 / 64) * (DM / 32), I_R = (DM / 64) * (DM / 32), I_L = 2 * 4;
        constexpr int NITEMS = 2 * I_IN + 2 * I_A + 4 * I_R + 128 * I_L;
        for (int it = gw; it < NITEMS; it += NGW) {
            int r = it;
            if (r < 2 * I_IN) { const int l = r / I_IN; p0_transpose_item(a.in[2] + (size_t)l * DM * NIN, DM, NIN, WIN + (size_t)l * NIN * DM, scr, r % I_IN, lane); continue; } r -= 2 * I_IN;
            if (r < 2 * I_A) { const int l = r / I_A; p0_transpose_item(a.in[9] + (size_t)l * 512 * DM, 512, DM, WA + (size_t)l * DM * 512, scr, r % I_A, lane); continue; } r -= 2 * I_A;
            if (r < 2 * I_R) { const int l = r / I_R; p0_transpose_item(a.in[10] + (size_t)l * DM * DM, DM, DM, WR + (size_t)l * DM * DM, scr, r % I_R, lane); continue; } r -= 2 * I_R;
            if (r < 2 * I_R) { const int l = r / I_R; p0_transpose_item(a.in[11] + (size_t)l * DM * DM, DM, DM, WO + (size_t)l * DM * DM, scr, r % I_R, lane); continue; } r -= 2 * I_R;
            { const int mtx = r / I_L; p0_transpose_item(a.in[6] + (size_t)mtx * 16384, 128, 128, LW + (size_t)mtx * 16384, scr, r % I_L, lane); }
        }
        const int gt = bid * 512 + tid, GT = G * 512;
        for (int i = gt; i < NTOK * (DM / 8); i += GT) {
            const size_t e = (size_t)i * 8; const float* src = (e < (size_t)8192 * DM) ? (a.in[0] + e) : (a.in[1] + (e - (size_t)8192 * DM));
            const f32x4 x0 = *(const f32x4*)src, x1 = *(const f32x4*)(src + 4);
            u32x4 o; o.x = cvt_pk_bf16(x0[0], x0[1]); o.y = cvt_pk_bf16(x0[2], x0[3]); o.z = cvt_pk_bf16(x1[0], x1[1]); o.w = cvt_pk_bf16(x1[2], x1[3]);
            *(u32x4*)(XB + e) = o;
        }
        for (int i = gt; i < 12 * 129; i += GT) { const int hd = i / 129, k = i % 129; biasTab[i] = a.in[14][(int)T5B[hd >> 2][k] * 12 + hd] * LOG2E; }
    }
    grid.sync();

#pragma nounroll
    for (int step = 0; step < 6; ++step) {
        const int l = step / 3, b = step - 3 * l;
        const int S = (b == 0) ? 8192 : 16384; const int rowoff = (b == 0) ? 0 : 8192 + (b - 1) * 16384;
        float* outb = a.out + (size_t)rowoff * DM;
        { pg8::Gemm g{XB + (size_t)rowoff * DM, WIN + (size_t)l * NIN * DM, S, NIN, DM, DM}; pg8::StaticOrder so; so.init(S, NIN, G, bid);
          pg8::EpiIn E{Z, NIN, a.in[3] + (size_t)l * NIN}; pg8::gemm_phase<pg8::EpiIn>(lds, g, so, E); }
        grid.sync();
        attn_phase(lds, Z, S, LSE, biasTab, bid, G);
        lru_phase<0>(lds, Z, S, a.in[4] + (size_t)l * 4 * DM, a.in[5] + (size_t)l * DM, LW + (size_t)l * 64 * 16384, a.in[7] + (size_t)l * 64 * 128, a.in[8] + (size_t)l * 2 * DM, AGG, CARRY, bid, G);
        grid.sync();
        carry_phase(AGG, CARRY, S, bid, G);
        grid.sync();
        lru_phase<1>(lds, Z, S, a.in[4] + (size_t)l * 4 * DM, a.in[5] + (size_t)l * DM, LW + (size_t)l * 64 * 16384, a.in[7] + (size_t)l * 64 * 128, a.in[8] + (size_t)l * 2 * DM, AGG, CARRY, bid, G);
        combine_phase(Z, S, LSE, bid, G);
        grid.sync();
        { pg8::Gemm g{Z + C_GA, WA + (size_t)l * DM * 512, S, DM, 512, NIN}; pg8::StaticOrder so; so.init(S, DM, G, bid);
          pg8::EpiGateA E{Z}; pg8::gemm_phase<pg8::EpiGateA>(lds, g, so, E); }
        { pg8::Gemm g{Z + C_GR, WR + (size_t)l * DM * DM, S, DM, DM, NIN}; pg8::StaticOrder so; so.init(S, DM, G, bid);
          pg8::EpiGateR E{Z}; pg8::gemm_phase<pg8::EpiGateR>(lds, g, so, E); }
        grid.sync();
        { const float* xin = (l == 0) ? ((b == 0) ? a.in[0] : a.in[1] + (size_t)(b - 1) * 16384 * DM) : outb;
          pg8::Gemm g{Z + C_M, WO + (size_t)l * DM * DM, S, DM, DM, NIN}; pg8::StaticOrder so; so.init(S, DM, G, bid);
          pg8::EpiRes E{xin, outb}; pg8::gemm_phase<pg8::EpiRes>(lds, g, so, E); }
        grid.sync();
        ln_phase(outb, (l == 0) ? (XB + (size_t)rowoff * DM) : (bf16_t*)nullptr, S, a.in[12] + (size_t)l * DM, a.in[13] + (size_t)l * DM, bid, G);
    }
}

extern "C" void kernel_launch(void* const* d_in, const int* in_sizes, int n_in, void* d_out, int out_size, void* d_ws, size_t ws_size, hipStream_t stream) {
    static int grid = 0;
    if (grid == 0) {
        if (n_in != 15 || out_size != NTOK * DM || ws_size < WS_END) { fprintf(stderr, "kernel_launch: unexpected shapes (n_in %d out %d ws %zu)\n", n_in, out_size, ws_size); grid = -1; return; }
        int dev = 0, cus = 0, per_cu = 0;
        (void)hipGetDevice(&dev);
        (void)hipDeviceGetAttribute(&cus, hipDeviceAttributeMultiprocessorCount, dev);
        (void)hipFuncSetAttribute((const void*)fwd_kernel, hipFuncAttributeMaxDynamicSharedMemorySize, LDS_BYTES);
        (void)hipOccupancyMaxActiveBlocksPerMultiprocessor(&per_cu, (const void*)fwd_kernel, 512, LDS_BYTES);
        if (per_cu < 1) per_cu = 1;
        grid = cus * per_cu;
    }
    if (grid < 0) return;
    Args a{};
    for (int i = 0; i < 15; ++i) a.in[i] = (const float*)d_in[i];
    a.out = (float*)d_out; a.ws = (unsigned char*)d_ws;
    void* args[] = {&a};
    hipError_t e = hipLaunchCooperativeKernel((const void*)fwd_kernel, dim3(grid), dim3(512), args, LDS_BYTES, stream);
    if (e != hipSuccess) fprintf(stderr, "cooperative launch failed: %s (grid %d)\n", hipGetErrorString(e), grid);
}
```

```cpp
#include <hip/hip_runtime.h>
#include <hip/hip_cooperative_groups.h>
#include <cstdio>
#include <cstdint>
namespace cg = cooperative_groups;

#define LAS __attribute__((address_space(3)))
typedef unsigned short bf16_t;
typedef short bf16x8 __attribute__((ext_vector_type(8)));
typedef short s16x4 __attribute__((ext_vector_type(4)));
typedef float f32x4 __attribute__((ext_vector_type(4)));
typedef float f32x2 __attribute__((ext_vector_type(2)));
typedef unsigned u32x4 __attribute__((ext_vector_type(4)));
typedef unsigned u32x2 __attribute__((ext_vector_type(2)));

constexpr int DM = 2048, NIN = 13312, NTOK = 40960;
constexpr int C_Q = 0, C_K = 1536, C_V = 3072, C_GA = 4608, C_XR = 5120, C_GR = 7168, C_GM = 9216;
constexpr int C_TA = 1536;
constexpr int C_M = C_XR;
constexpr float ALPHA = 1.4142135623730951f, LN_EPS = 1e-5f;
constexpr float LOG2E = 1.4426950408889634f, LN2 = 0.6931471805599453f;

constexpr size_t MiB = 1u << 20;
constexpr size_t WS_BIAS = 1 * MiB, WS_WIN = 2 * MiB, WS_WA = 106 * MiB, WS_WR = 110 * MiB, WS_WO = 126 * MiB, WS_LW = 142 * MiB,
                 WS_XB = 146 * MiB, WS_Z = 306 * MiB, WS_LSE = 722 * MiB, WS_AGG = 723 * MiB, WS_CARRY = 731 * MiB, WS_END = 735 * MiB;
constexpr int LDS_BYTES = 147456;

__device__ const unsigned char T5B[3][129] = {
{11,11,11,11,11,11,11,11,11,11,11,11,11,11,11,10,10,10,10,10,10,10,10,10,10,10,10,10,10,10,10,10,10,10,10,10,10,10,9,9,9,9,9,9,9,9,9,9,9,9,8,8,8,8,8,8,8,7,6,5,4,3,2,1,0,17,18,19,20,21,22,23,24,24,24,24,24,24,24,25,25,25,25,25,25,25,25,25,25,25,25,26,26,26,26,26,26,26,26,26,26,26,26,26,26,26,26,26,26,26,26,26,26,26,27,27,27,27,27,27,27,27,27,27,27,27,27,27,27},
{13,13,13,13,13,13,13,13,13,13,13,13,13,13,13,13,13,13,13,13,13,13,13,12,12,12,12,12,12,12,12,12,12,12,12,12,12,12,12,12,12,12,11,11,11,11,11,11,11,11,11,11,10,10,10,10,10,10,9,9,9,8,8,4,0,20,24,24,25,25,25,26,26,26,26,26,26,27,27,27,27,27,27,27,27,27,27,28,28,28,28,28,28,28,28,28,28,28,28,28,28,28,28,28,28,28,29,29,29,29,29,29,29,29,29,29,29,29,29,29,29,29,29,29,29,29,29,29,29},
{15,15,15,15,15,15,15,15,15,15,15,15,15,15,15,15,15,15,15,15,15,15,15,15,15,15,15,15,15,15,14,14,14,14,14,14,14,14,14,14,14,14,14,14,14,13,13,13,13,13,13,13,13,13,12,12,12,12,12,11,11,10,10,9,0,25,26,26,27,27,28,28,28,28,28,29,29,29,29,29,29,29,29,29,30,30,30,30,30,30,30,30,30,30,30,30,30,30,30,31,31,31,31,31,31,31,31,31,31,31,31,31,31,31,31,31,31,31,31,31,31,31,31,31,31,31,31,31,31}};

__device__ __forceinline__ unsigned cvt_pk_bf16(float lo, float hi) { unsigned r; asm volatile("v_cvt_pk_bf16_f32 %0, %1, %2" : "=v"(r) : "v"(lo), "v"(hi)); return r; }
__device__ __forceinline__ float bf_lo(unsigned u) { return __uint_as_float(u << 16); }
__device__ __forceinline__ float bf_hi(unsigned u) { return __uint_as_float(u & 0xffff0000u); }
__device__ __forceinline__ float bf1(bf16_t u) { return __uint_as_float(((unsigned)u) << 16); }
__device__ __forceinline__ float sigm(float x) { return __builtin_amdgcn_rcpf(1.0f + __expf(-x)); }
__device__ __forceinline__ float silu(float x) { return x * sigm(x); }

namespace pg8 {
constexpr int BM = 256, BK = 64, HALF = 128, HTB = HALF * BK * 2, STAGE_BYTES = 8 * HTB, NXCD = 8, WGM = 8;
__host__ __device__ __forceinline__ int lds_byte(int r, int c) { const int st = (r >> 4) * 2 + (c >> 5), rr = r & 15, cc = c & 31, ob = rr * 64 + cc * 2; return st * 1024 + (ob ^ (((ob >> 9) & 1) << 5)); }
__host__ __device__ __forceinline__ void stage_rc(int b, int& R, int& C) { const int st = b / 1024, sb = b % 1024, swz = sb ^ (((sb >> 9) & 1) << 5); R = (st >> 1) * 16 + swz / 64; C = (st & 1) * 32 + (swz % 64) / 2; }
__host__ __device__ __forceinline__ int perm32(int rho) { const int n = rho >> 4, i = rho & 15; return 8 * (i >> 2) + 4 * n + (i & 3); }

struct Unit { int pm, pn; };
struct Gemm { const bf16_t* A; const bf16_t* Bt; int M, N, K, lda; };

struct StaticOrder {
    int nM, nN, nwg, G, c;
    __host__ __device__ void init(int M, int N, int G_, int c_) { nM = M / BM; nN = N / BM; nwg = nM * nN; G = G_; c = c_; }
    __host__ __device__ bool next(int i, Unit& u) const {
        const long L = (long)i * G + c; if (L >= nwg) return false;
        int wgid = (int)L; { const int q = nwg / NXCD, r = nwg % NXCD, xcd = wgid % NXCD, off = wgid / NXCD; wgid = (xcd < r ? xcd * (q + 1) : r * (q + 1) + (xcd - r) * q) + off; }
        const int nig = WGM * nN, gid = wgid / nig, fm = gid * WGM, gsz = (nM - fm) < WGM ? (nM - fm) : WGM;
        u.pm = fm + ((wgid % nig) % gsz); u.pn = (wgid % nig) / gsz; return true;
    }
};

struct EpiIn {
    bf16_t* O; int ldc; const float* bias;
    __device__ __forceinline__ void operator()(const f32x4 (&acc)[2][2][4][2], const Unit& u, int wr, int wc, int fr, int fq) const {
        const int row0 = u.pm * BM + wr * 64 + fr; const int col0 = u.pn * BM + wc * 32 + 8 * fq;
        f32x4 bv[2][2];
#pragma unroll
        for (int bj = 0; bj < 2; ++bj)
#pragma unroll
            for (int n = 0; n < 2; ++n) bv[bj][n] = *(const f32x4*)(bias + col0 + bj * HALF + 4 * n);
#pragma unroll
        for (int ai = 0; ai < 2; ++ai)
#pragma unroll
            for (int m = 0; m < 4; ++m) { bf16_t* rowp = O + (size_t)(row0 + ai * HALF + m * 16) * ldc + col0;
#pragma unroll
                for (int bj = 0; bj < 2; ++bj) { const f32x4 v0 = acc[ai][bj][m][0] + bv[bj][0], v1 = acc[ai][bj][m][1] + bv[bj][1];
                    u32x4 w; w.x = cvt_pk_bf16(v0[0], v0[1]); w.y = cvt_pk_bf16(v0[2], v0[3]); w.z = cvt_pk_bf16(v1[0], v1[1]); w.w = cvt_pk_bf16(v1[2], v1[3]);
                    *(u32x4*)(rowp + bj * HALF) = w; } }
    }
};
struct EpiGateA {
    bf16_t* Z;
    __device__ __forceinline__ void operator()(const f32x4 (&acc)[2][2][4][2], const Unit& u, int wr, int wc, int fr, int fq) const {
        const int row0 = u.pm * BM + wr * 64 + fr; const int col0 = u.pn * BM + wc * 32 + 8 * fq;
#pragma unroll
        for (int ai = 0; ai < 2; ++ai)
#pragma unroll
            for (int m = 0; m < 4; ++m) { bf16_t* zr = Z + (size_t)(row0 + ai * HALF + m * 16) * NIN + col0;
#pragma unroll
                for (int bj = 0; bj < 2; ++bj) { const f32x4 v0 = acc[ai][bj][m][0], v1 = acc[ai][bj][m][1];
                    const u32x4 g = *(const u32x4*)(zr + C_GM + bj * HALF);
                    u32x4 w; w.x = cvt_pk_bf16(v0[0] * sigm(bf_lo(g.x)), v0[1] * sigm(bf_hi(g.x))); w.y = cvt_pk_bf16(v0[2] * sigm(bf_lo(g.y)), v0[3] * sigm(bf_hi(g.y)));
                    w.z = cvt_pk_bf16(v1[0] * sigm(bf_lo(g.z)), v1[1] * sigm(bf_hi(g.z))); w.w = cvt_pk_bf16(v1[2] * sigm(bf_lo(g.w)), v1[3] * sigm(bf_hi(g.w)));
                    *(u32x4*)(zr + C_TA + bj * HALF) = w; } }
    }
};
struct EpiGateR {
    bf16_t* Z;
    __device__ __forceinline__ void operator()(const f32x4 (&acc)[2][2][4][2], const Unit& u, int wr, int wc, int fr, int fq) const {
        const int row0 = u.pm * BM + wr * 64 + fr; const int col0 = u.pn * BM + wc * 32 + 8 * fq;
#pragma unroll
        for (int ai = 0; ai < 2; ++ai)
#pragma unroll
            for (int m = 0; m < 4; ++m) { bf16_t* zr = Z + (size_t)(row0 + ai * HALF + m * 16) * NIN + col0;
#pragma unroll
                for (int bj = 0; bj < 2; ++bj) { const f32x4 v0 = acc[ai][bj][m][0], v1 = acc[ai][bj][m][1];
                    const u32x4 g = *(const u32x4*)(zr + C_GM + DM + bj * HALF);
                    const u32x4 t = *(const u32x4*)(zr + C_TA + bj * HALF);
                    u32x4 w; w.x = cvt_pk_bf16(bf_lo(t.x) + v0[0] * sigm(bf_lo(g.x)), bf_hi(t.x) + v0[1] * sigm(bf_hi(g.x)));
                    w.y = cvt_pk_bf16(bf_lo(t.y) + v0[2] * sigm(bf_lo(g.y)), bf_hi(t.y) + v0[3] * sigm(bf_hi(g.y)));
                    w.z = cvt_pk_bf16(bf_lo(t.z) + v1[0] * sigm(bf_lo(g.z)), bf_hi(t.z) + v1[1] * sigm(bf_hi(g.z)));
                    w.w = cvt_pk_bf16(bf_lo(t.w) + v1[2] * sigm(bf_lo(g.w)), bf_hi(t.w) + v1[3] * sigm(bf_hi(g.w)));
                    *(u32x4*)(zr + C_M + bj * HALF) = w; } }
    }
};
struct EpiRes {
    const float* xin; float* out;
    __device__ __forceinline__ void operator()(const f32x4 (&acc)[2][2][4][2], const Unit& u, int wr, int wc, int fr, int fq) const {
        const int row0 = u.pm * BM + wr * 64 + fr; const int col0 = u.pn * BM + wc * 32 + 8 * fq;
#pragma unroll
        for (int ai = 0; ai < 2; ++ai)
#pragma unroll
            for (int m = 0; m < 4; ++m) { const size_t off = (size_t)(row0 + ai * HALF + m * 16) * DM + col0;
#pragma unroll
                for (int bj = 0; bj < 2; ++bj) {
                    const f32x4 x0 = *(const f32x4*)(xin + off + bj * HALF), x1 = *(const f32x4*)(xin + off + bj * HALF + 4);
                    const f32x4 o0 = x0 * ALPHA + acc[ai][bj][m][0], o1 = x1 * ALPHA + acc[ai][bj][m][1];
                    *(f32x4*)(out + off + bj * HALF) = o0; *(f32x4*)(out + off + bj * HALF + 4) = o1; } }
    }
};

template <class Epi>
__device__ __forceinline__ void gemm_phase(LAS unsigned char* lds, const Gemm g, const StaticOrder& S, const Epi& E) {
    int tid = threadIdx.x; asm volatile("" : "+v"(tid));
    const int wid = __builtin_amdgcn_readfirstlane(tid >> 6), lane = tid & 63, wr = wid >> 2, wc = wid & 3, fr = lane & 15, fq = lane >> 4;
    const int K = g.K, nt = K / BK, lda = g.lda;
    unsigned voffA[2], voffB[2];
#pragma unroll
    for (int i = 0; i < 2; ++i) { int R, C; stage_rc(tid * 16 + i * 8192, R, C); const int Rb = (R & ~31) + perm32(R & 31);
        voffA[i] = (unsigned)(R * lda + C) * 2u; voffB[i] = (unsigned)(Rb * K + C) * 2u; }
    const size_t kstep = (size_t)(BK * 2);
    const size_t hstepA = (size_t)HALF * lda * 2, hstepB = (size_t)HALF * K * 2;
    const size_t tstepA = 2 * hstepA, tstepB = 2 * hstepB;
    const unsigned ldsw = (unsigned)wid * 1024u;
    const int aoff = lds_byte(wr * 64 + fr, fq * 8), boff = lds_byte(wc * 32 + fr, fq * 8);
#define PG8_SA(b, h) (((b) * 2 + (h)) * HTB)
#define PG8_SB(b, h) ((4 + (b) * 2 + (h)) * HTB)
#define PG8_STAGE(bufoff, gbase, voff) do { _Pragma("unroll") for (int _i = 0; _i < 2; ++_i) \
        __builtin_amdgcn_global_load_lds((const unsigned*)((const char*)(gbase) + (voff)[_i]), (LAS unsigned*)(lds + (bufoff) + ldsw + _i * 8192), 16, 0, 0); } while (0)
#define PG8_LDA(dst, b, h) do { _Pragma("unroll") for (int m = 0; m < 4; ++m) _Pragma("unroll") for (int k = 0; k < 2; ++k) dst[m][k] = *(const LAS bf16x8*)(lds + PG8_SA(b, h) + aoff + m * 2048 + k * 1024); } while (0)
#define PG8_LDB(dst, b, h) do { _Pragma("unroll") for (int n = 0; n < 2; ++n) _Pragma("unroll") for (int k = 0; k < 2; ++k) dst[n][k] = *(const LAS bf16x8*)(lds + PG8_SB(b, h) + boff + n * 2048 + k * 1024); } while (0)
#define PG8_MMA(ai, bj, At, Bt) do { __builtin_amdgcn_s_setprio(1); _Pragma("unroll") for (int m = 0; m < 4; ++m) _Pragma("unroll") for (int n = 0; n < 2; ++n) _Pragma("unroll") for (int k = 0; k < 2; ++k) \
        acc[ai][bj][m][n] = __builtin_amdgcn_mfma_f32_16x16x32_bf16(Bt[n][k], At[m][k], acc[ai][bj][m][n], 0, 0, 0); __builtin_amdgcn_s_setprio(0); } while (0)
#define PG8_WAIT_V(n) asm volatile("s_waitcnt vmcnt(" #n ")" ::: "memory")
#define PG8_WAIT_L(n) asm volatile("s_waitcnt lgkmcnt(" #n ")" ::: "memory")
#define PG8_BAR __builtin_amdgcn_s_barrier()
#define PG8_SCHED __builtin_amdgcn_sched_barrier(0)
    Unit cur, nxt; int ui = 0;
    if (!S.next(0, cur)) return;
    f32x4 acc[2][2][4][2];
#pragma unroll
    for (int a = 0; a < 2; ++a)
#pragma unroll
        for (int b = 0; b < 2; ++b)
#pragma unroll
            for (int m = 0; m < 4; ++m)
#pragma unroll
                for (int n = 0; n < 2; ++n) acc[a][b][m][n] = (f32x4){0.f, 0.f, 0.f, 0.f};
    bf16x8 At[4][2], B0[2][2], B1[2][2];
    const char* cA = (const char*)g.A + (size_t)cur.pm * tstepA; const char* cB = (const char*)g.Bt + (size_t)cur.pn * tstepB;
    PG8_STAGE(PG8_SB(0, 0), cB, voffB); PG8_STAGE(PG8_SB(0, 1), cB + hstepB, voffB); PG8_STAGE(PG8_SA(0, 0), cA, voffA); PG8_STAGE(PG8_SA(0, 1), cA + hstepA, voffA);
    if (wr == 1) PG8_BAR;
    PG8_WAIT_V(2); PG8_BAR;
    PG8_STAGE(PG8_SB(1, 0), cB + kstep, voffB); PG8_STAGE(PG8_SA(1, 0), cA + kstep, voffA); PG8_STAGE(PG8_SB(1, 1), cB + hstepB + kstep, voffB);
    PG8_WAIT_V(6); PG8_BAR;
    for (;;) {
        const bool has_next = S.next(ui + 1, nxt);
        const char* nA = has_next ? (const char*)g.A + (size_t)nxt.pm * tstepA : cA; const char* nB = has_next ? (const char*)g.Bt + (size_t)nxt.pn * tstepB : cB;
        for (int t = 0; t < nt; t += 2) {
            const bool last = (t == nt - 2);
            const char* a1 = cA + (size_t)(t + 1) * kstep;
            const char* a2 = last ? nA : cA + (size_t)(t + 2) * kstep; const char* b2 = last ? nB : cB + (size_t)(t + 2) * kstep;
            const char* a3 = a2 + kstep; const char* b3 = b2 + kstep;
            PG8_LDB(B0, 0, 0); PG8_LDB(B1, 0, 1); PG8_SCHED; PG8_LDA(At, 0, 0); PG8_STAGE(PG8_SA(1, 1), a1 + hstepA, voffA);
            PG8_WAIT_V(8); PG8_WAIT_L(0); PG8_BAR; PG8_MMA(0, 0, At, B0); PG8_MMA(0, 1, At, B1); PG8_BAR; PG8_SCHED;
            PG8_LDA(At, 0, 1); PG8_STAGE(PG8_SB(0, 0), b2, voffB); PG8_STAGE(PG8_SB(0, 1), b2 + hstepB, voffB); PG8_STAGE(PG8_SA(0, 0), a2, voffA);
            PG8_WAIT_V(8); PG8_WAIT_L(0); PG8_BAR; PG8_MMA(1, 0, At, B0); PG8_MMA(1, 1, At, B1); PG8_BAR; PG8_SCHED;
            PG8_LDB(B0, 1, 0); PG8_LDB(B1, 1, 1); PG8_SCHED; PG8_LDA(At, 1, 0); PG8_STAGE(PG8_SA(0, 1), a2 + hstepA, voffA);
            PG8_WAIT_V(8); PG8_WAIT_L(0); PG8_BAR; PG8_MMA(0, 0, At, B0); PG8_MMA(0, 1, At, B1); PG8_BAR; PG8_SCHED;
            PG8_LDA(At, 1, 1); PG8_STAGE(PG8_SB(1, 0), b3, voffB); PG8_STAGE(PG8_SB(1, 1), b3 + hstepB, voffB); PG8_STAGE(PG8_SA(1, 0), a3, voffA);
            PG8_WAIT_V(8); PG8_WAIT_L(0); PG8_BAR; PG8_MMA(1, 0, At, B0); PG8_MMA(1, 1, At, B1); PG8_BAR; PG8_SCHED;
        }
        if (wr == 0) PG8_BAR;
        E(acc, cur, wr, wc, fr, fq);
        if (!has_next) break;
#pragma unroll
        for (int a = 0; a < 2; ++a)
#pragma unroll
            for (int b = 0; b < 2; ++b)
#pragma unroll
                for (int m = 0; m < 4; ++m)
#pragma unroll
                    for (int n = 0; n < 2; ++n) acc[a][b][m][n] = (f32x4){0.f, 0.f, 0.f, 0.f};
        cur = nxt; cA = nA; cB = nB; ++ui;
        if (wr == 1) PG8_BAR;
    }
    PG8_WAIT_V(0);
    PG8_BAR;
#undef PG8_SA
#undef PG8_SB
#undef PG8_STAGE
#undef PG8_LDA
#undef PG8_LDB
#undef PG8_MMA
#undef PG8_WAIT_V
#undef PG8_WAIT_L
#undef PG8_BAR
#undef PG8_SCHED
}
}

__device__ __forceinline__ unsigned f2bf(float f) { unsigned u = __builtin_bit_cast(unsigned, f); return (u + 0x7fffu + ((u >> 16) & 1u)) >> 16; }
__device__ __forceinline__ unsigned pk2(float lo, float hi) { return f2bf(lo) | (f2bf(hi) << 16); }
__device__ __forceinline__ void p0_transpose_item(const float* W, int K, int N, bf16_t* WT, LAS float* scr, int item, int lane) {
    const int nblk = N / 32, kb = item / nblk, nb = item % nblk, k0 = 64 * kb, n0 = 32 * nb;
#pragma unroll 8
    for (int i = 0; i < 32; ++i) { const int kk = 2 * i + (lane >> 5); scr[kk * 33 + (lane & 31)] = W[(size_t)(k0 + kk) * N + n0 + (lane & 31)]; }
    asm volatile("s_waitcnt lgkmcnt(0)" ::: "memory");
    const int c = lane & 7;
#pragma unroll
    for (int j = 0; j < 4; ++j) { const int n = (lane >> 3) + 8 * j; const LAS float* s = scr + (8 * c) * 33 + n;
        u32x4 o; o.x = pk2(s[0 * 33], s[1 * 33]); o.y = pk2(s[2 * 33], s[3 * 33]); o.z = pk2(s[4 * 33], s[5 * 33]); o.w = pk2(s[6 * 33], s[7 * 33]);
        *(u32x4*)(WT + (size_t)(n0 + n) * K + k0 + 8 * c) = o; }
    asm volatile("s_waitcnt lgkmcnt(0)" ::: "memory");
}

constexpr int KVS = 272;
constexpr int LDS_K = 0, LDS_V = 256 * KVS, LDS_SB = 2 * 256 * KVS;
__device__ __forceinline__ void attn_phase(LAS unsigned char* lds, bf16_t* Z, int S, float* lse, const float* biasTab, int bid, int G) {
    int tid = threadIdx.x; asm volatile("" : "+v"(tid));
    const int lane = tid & 63, w = __builtin_amdgcn_readfirstlane(tid >> 6), l15 = lane & 15, quad = lane >> 4;
    const int nunits = 12 * (S >> 7);
    for (int u = bid; u < nunits; u += G) {
        const int hd = u % 12, rest = u / 12, g = hd >> 2, dsh = 2 * g;
        const int Lsub = S >> dsh, cpr = Lsub >> 7, r = rest / cpr, jc = rest - r * cpr, j0 = jc << 7;
        {
            const int c = tid & 15, rbase = tid >> 4;
            u32x4 kk[8], vv[8];
#pragma unroll
            for (int it = 0; it < 8; ++it) { const int i = rbase + 32 * it, j = j0 - 64 + i; const bool ok = (j >= 0) && (j < Lsub);
                const int jcl = ok ? j : 0; const bf16_t* p = Z + ((size_t)((jcl << dsh) + r)) * NIN + hd * 128 + c * 8;
                u32x4 a = *(const u32x4*)(p + C_K), b = *(const u32x4*)(p + C_V);
                if (!ok) { a = (u32x4){0u, 0u, 0u, 0u}; b = a; }
                kk[it] = a; vv[it] = b; }
#pragma unroll
            for (int it = 0; it < 8; ++it) { const int i = rbase + 32 * it;
                *(LAS u32x4*)(lds + LDS_K + i * KVS + c * 16) = kk[it]; *(LAS u32x4*)(lds + LDS_V + i * KVS + c * 16) = vv[it]; }
            if (tid < 129) ((LAS float*)(lds + LDS_SB))[tid] = biasTab[hd * 129 + tid];
        }
        const int jq = j0 + 16 * w + l15; const size_t tokq = ((size_t)jq << dsh) + r;
        bf16_t* qrow = Z + tokq * NIN + hd * 128;
        bf16x8 qf[4];
#pragma unroll
        for (int ks = 0; ks < 4; ++ks) qf[ks] = *(const bf16x8*)(qrow + ks * 32 + quad * 8);
        __syncthreads();
        f32x4 sacc[9];
        const LAS unsigned char* kbase = lds + LDS_K + (16 * w + l15) * KVS + quad * 16;
#pragma unroll
        for (int kt = 0; kt < 9; ++kt) { f32x4 a4 = (f32x4){0.f, 0.f, 0.f, 0.f};
#pragma unroll
            for (int ks = 0; ks < 4; ++ks) { const bf16x8 a = *(const LAS bf16x8*)(kbase + kt * 16 * KVS + ks * 64); a4 = __builtin_amdgcn_mfma_f32_16x16x32_bf16(a, qf[ks], a4, 0, 0, 0); }
            sacc[kt] = a4; }
        const float sc = 0.08838834764831845f * LOG2E;
        const LAS float* sb = (const LAS float*)(lds + LDS_SB);
        float mx = -1e30f;
#pragma unroll
        for (int kt = 0; kt < 9; ++kt)
#pragma unroll
            for (int i = 0; i < 4; ++i) { const int c = 16 * kt + 4 * quad + i, o64 = c - l15, jk = j0 + 16 * w - 64 + c;
                const bool valid = (o64 >= 0) && (o64 <= 128) && (jk >= 0) && (jk < Lsub);
                const int oc = o64 < 0 ? 0 : (o64 > 128 ? 128 : o64);
                const float s = valid ? (sacc[kt][i] * sc + sb[oc]) : -1e30f;
                sacc[kt][i] = s; mx = fmaxf(mx, s); }
        mx = fmaxf(mx, __shfl_xor(mx, 16)); mx = fmaxf(mx, __shfl_xor(mx, 32));
        float den = 0.f;
#pragma unroll
        for (int kt = 0; kt < 9; ++kt)
#pragma unroll
            for (int i = 0; i < 4; ++i) { const float p = __builtin_amdgcn_exp2f(sacc[kt][i] - mx); sacc[kt][i] = p; den += p; }
        den += __shfl_xor(den, 16); den += __shfl_xor(den, 32);
        bf16x8 pb[5];
#pragma unroll
        for (int s = 0; s < 5; ++s) { const f32x4 lo = sacc[2 * s]; const f32x4 hi = (2 * s + 1 < 9) ? sacc[(2 * s + 1 < 9) ? 2 * s + 1 : 8] : (f32x4){0.f, 0.f, 0.f, 0.f};
            u32x4 pk; pk.x = cvt_pk_bf16(lo[0], lo[1]); pk.y = cvt_pk_bf16(lo[2], lo[3]); pk.z = cvt_pk_bf16(hi[0], hi[1]); pk.w = cvt_pk_bf16(hi[2], hi[3]);
            pb[s] = __builtin_bit_cast(bf16x8, pk); }
        f32x4 oacc[8];
        const LAS unsigned char* vbase = lds + LDS_V + (16 * w + 4 * quad + (l15 >> 2)) * KVS + (l15 & 3) * 8;
#pragma unroll
        for (int dt = 0; dt < 8; ++dt) { f32x4 o4 = (f32x4){0.f, 0.f, 0.f, 0.f};
#pragma unroll
            for (int s = 0; s < 5; ++s) {
                const s16x4 lo = __builtin_bit_cast(s16x4, __builtin_amdgcn_ds_read_tr16_b64_v4i16((LAS s16x4*)(vbase + (s * 32) * KVS + dt * 32)));
                s16x4 hi = (s16x4){0, 0, 0, 0};
                if (s < 4) hi = __builtin_bit_cast(s16x4, __builtin_amdgcn_ds_read_tr16_b64_v4i16((LAS s16x4*)(vbase + (s * 32 + 16) * KVS + dt * 32)));
                const bf16x8 a = (bf16x8){lo[0], lo[1], lo[2], lo[3], hi[0], hi[1], hi[2], hi[3]};
                o4 = __builtin_amdgcn_mfma_f32_16x16x32_bf16(a, pb[s], o4, 0, 0, 0); }
            oacc[dt] = o4; }
        const float inv = 1.0f / den;
#pragma unroll
        for (int dt = 0; dt < 8; ++dt) { u32x2 o2; o2.x = cvt_pk_bf16(oacc[dt][0] * inv, oacc[dt][1] * inv); o2.y = cvt_pk_bf16(oacc[dt][2] * inv, oacc[dt][3] * inv);
            *(u32x2*)(qrow + 16 * dt + 4 * quad) = o2; }
        if (quad == 0) lse[tokq * 12 + hd] = (mx + __log2f(den)) * LN2;
        __syncthreads();
    }
}

__device__ __forceinline__ void combine_phase(bf16_t* Z, int S, const float* lse, int bid, int G) {
    int tid = threadIdx.x; asm volatile("" : "+v"(tid));
    const int lane = tid & 63, gw = bid * 8 + (tid >> 6), NGW = G * 8;
    const int h = lane >> 4, dc = lane & 15;
    for (int row = gw; row < S; row += NGW) {
        bf16_t* zr = Z + (size_t)row * NIN;
        const float l0 = lse[(size_t)row * 12 + h], l1 = lse[(size_t)row * 12 + 4 + h], l2 = lse[(size_t)row * 12 + 8 + h];
        const float m = fmaxf(l0, fmaxf(l1, l2));
        float e0 = __expf(l0 - m), e1 = __expf(l1 - m), e2 = __expf(l2 - m); const float inv = 1.0f / (e0 + e1 + e2); e0 *= inv; e1 *= inv; e2 *= inv;
        const u32x4 a = *(const u32x4*)(zr + (0 + h) * 128 + dc * 8), b = *(const u32x4*)(zr + (4 + h) * 128 + dc * 8), c = *(const u32x4*)(zr + (8 + h) * 128 + dc * 8);
        const u32x4 ga = *(const u32x4*)(zr + C_GA + h * 128 + dc * 8);
        u32x4 o;
#define CMB(f) o.f = cvt_pk_bf16((e0 * bf_lo(a.f) + e1 * bf_lo(b.f) + e2 * bf_lo(c.f)) * silu(bf_lo(ga.f)), (e0 * bf_hi(a.f) + e1 * bf_hi(b.f) + e2 * bf_hi(c.f)) * silu(bf_hi(ga.f)))
        CMB(x); CMB(y); CMB(z); CMB(w);
#undef CMB
        *(u32x4*)(zr + C_GA + h * 128 + dc * 8) = o;
    }
}

constexpr int XCF_STRIDE = 132, LDS_XCF = 0, LDS_XCB = 64 * XCF_STRIDE * 4, LDS_CW = LDS_XCB + 64 * KVS;
__device__ __forceinline__ float sigm2(float x) { return __builtin_amdgcn_rcpf(1.0f + __builtin_amdgcn_exp2f(x * -LOG2E)); }
template <int PASS>
__device__ __forceinline__ void lru_phase(LAS unsigned char* lds, bf16_t* Z, int S, const float* convw, const float* convb, const bf16_t* LWt, const float* lrub, const float* lam,
                                          f32x2* __restrict__ AGG, const float* __restrict__ CARRY, int bid, int G) {
    int tid = threadIdx.x; asm volatile("" : "+v"(tid));
    const int lane = tid & 63, w = __builtin_amdgcn_readfirstlane(tid >> 6), l15 = lane & 15, quad = lane >> 4;
    LAS float* xcf = (LAS float*)(lds + LDS_XCF);
    LAS float* cw = (LAS float*)(lds + LDS_CW);
    const int nb16 = G >> 4, n = bid & 15, cfirst = bid >> 4, NC = S >> 6;
    if (cfirst >= nb16) return;
    const int chl = 16 * w + l15, ch = n * 128 + chl;
    for (int i = tid; i < 5 * 128; i += 512) { const int j = i >> 7, ci = i & 127; cw[i] = (j < 4) ? convw[j * DM + n * 128 + ci] : convb[n * 128 + ci]; }
    bf16x8 bw[2][2][4]; float br[2], bi[2], k8[2];
#pragma unroll
    for (int dir = 0; dir < 2; ++dir) {
#pragma unroll
        for (int gt = 0; gt < 2; ++gt)
#pragma unroll
            for (int ks = 0; ks < 4; ++ks) bw[dir][gt][ks] = *(const bf16x8*)(LWt + ((size_t)(((dir * 2 + gt) * 16 + n) * 128 + chl)) * 128 + ks * 32 + quad * 8);
        br[dir] = lrub[((dir * 2 + 0) * 16 + n) * 128 + chl]; bi[dir] = lrub[((dir * 2 + 1) * 16 + n) * 128 + chl];
        k8[dir] = -8.0f * LOG2E * log1pf(__expf(-lam[dir * DM + ch]));
    }
    __syncthreads();
    for (int c = cfirst; c < NC; c += nb16) {
        const int t0 = c * 64;
#pragma unroll
        for (int k = 0; k < 2; ++k) { const int item = tid + 512 * k, tt = item >> 4, cc = item & 15;
            f32x4 x0 = *(const LAS f32x4*)(cw + 4 * 128 + cc * 8), x1 = *(const LAS f32x4*)(cw + 4 * 128 + cc * 8 + 4);
#pragma unroll
            for (int j = 0; j < 4; ++j) { const int row = t0 + tt + j - 2;
                if (row >= 0 && row < S) { const u32x4 x = *(const u32x4*)(Z + (size_t)row * NIN + C_XR + n * 128 + cc * 8);
                    const f32x4 w0 = *(const LAS f32x4*)(cw + j * 128 + cc * 8), w1 = *(const LAS f32x4*)(cw + j * 128 + cc * 8 + 4);
                    x0[0] += bf_lo(x.x) * w0[0]; x0[1] += bf_hi(x.x) * w0[1]; x0[2] += bf_lo(x.y) * w0[2]; x0[3] += bf_hi(x.y) * w0[3];
                    x1[0] += bf_lo(x.z) * w1[0]; x1[1] += bf_hi(x.z) * w1[1]; x1[2] += bf_lo(x.w) * w1[2]; x1[3] += bf_hi(x.w) * w1[3]; } }
            *(LAS f32x4*)(xcf + tt * XCF_STRIDE + cc * 8) = x0; *(LAS f32x4*)(xcf + tt * XCF_STRIDE + cc * 8 + 4) = x1;
            u32x4 pk; pk.x = cvt_pk_bf16(x0[0], x0[1]); pk.y = cvt_pk_bf16(x0[2], x0[3]); pk.z = cvt_pk_bf16(x1[0], x1[1]); pk.w = cvt_pk_bf16(x1[2], x1[3]);
            *(LAS u32x4*)(lds + LDS_XCB + tt * KVS + cc * 16) = pk; }
        __syncthreads();
        float hsum[4][4];
#pragma unroll
        for (int dir = 0; dir < 2; ++dir) {
            f32x4 ga[2][4];
#pragma unroll
            for (int mt = 0; mt < 4; ++mt) { ga[0][mt] = (f32x4){0.f, 0.f, 0.f, 0.f}; ga[1][mt] = (f32x4){0.f, 0.f, 0.f, 0.f};
#pragma unroll
                for (int ks = 0; ks < 4; ++ks) { const bf16x8 a = *(const LAS bf16x8*)(lds + LDS_XCB + (16 * mt + l15) * KVS + ks * 64 + quad * 16);
                    ga[0][mt] = __builtin_amdgcn_mfma_f32_16x16x32_bf16(a, bw[dir][0][ks], ga[0][mt], 0, 0, 0);
                    ga[1][mt] = __builtin_amdgcn_mfma_f32_16x16x32_bf16(a, bw[dir][1][ks], ga[1][mt], 0, 0, 0); } }
            float av[4][4], bv[4][4];
#pragma unroll
            for (int mt = 0; mt < 4; ++mt)
#pragma unroll
                for (int i = 0; i < 4; ++i) { const float rg = sigm2(ga[0][mt][i] + br[dir]), ig = sigm2(ga[1][mt][i] + bi[dir]);
                    const float xcv = xcf[(16 * mt + 4 * quad + i) * XCF_STRIDE + chl];
                    const float av_ = __builtin_amdgcn_exp2f(k8[dir] * rg);
                    av[mt][i] = av_; bv[mt][i] = __builtin_amdgcn_sqrtf(fmaxf(1.0f - av_ * av_, 0.f)) * (ig * xcv); }
            float H = 0.f, Ptot = 1.f;
            if (PASS == 1) H = CARRY[(size_t)(c * 2 + dir) * DM + ch];
            if (dir == 0) {
#pragma unroll
                for (int mt = 0; mt < 4; ++mt) {
                    float As = av[mt][0] * av[mt][1] * av[mt][2] * av[mt][3];
                    float Bs = ((bv[mt][0] * av[mt][1] + bv[mt][1]) * av[mt][2] + bv[mt][2]) * av[mt][3] + bv[mt][3];
                    float Ap = __shfl_up(As, 16), Bp = __shfl_up(Bs, 16); if (quad >= 1) { Bs = As * Bp + Bs; As = Ap * As; }
                    Ap = __shfl_up(As, 32); Bp = __shfl_up(Bs, 32); if (quad >= 2) { Bs = As * Bp + Bs; As = Ap * As; }
                    float Ae = __shfl_up(As, 16), Be = __shfl_up(Bs, 16); if (quad == 0) { Ae = 1.f; Be = 0.f; }
                    const float At = __shfl(As, 48 + l15), Bt = __shfl(Bs, 48 + l15);
                    float h = Ae * H + Be; H = At * H + Bt; Ptot *= At;
#pragma unroll
                    for (int i = 0; i < 4; ++i) { h = av[mt][i] * h + bv[mt][i]; hsum[mt][i] = h; }
                }
            } else {
#pragma unroll
                for (int mt = 3; mt >= 0; --mt) {
                    float As = av[mt][3] * av[mt][2] * av[mt][1] * av[mt][0];
                    float Bs = ((bv[mt][3] * av[mt][2] + bv[mt][2]) * av[mt][1] + bv[mt][1]) * av[mt][0] + bv[mt][0];
                    float Ap = __shfl_down(As, 16), Bp = __shfl_down(Bs, 16); if (quad <= 2) { Bs = As * Bp + Bs; As = Ap * As; }
                    Ap = __shfl_down(As, 32); Bp = __shfl_down(Bs, 32); if (quad <= 1) { Bs = As * Bp + Bs; As = Ap * As; }
                    float Ae = __shfl_down(As, 16), Be = __shfl_down(Bs, 16); if (quad == 3) { Ae = 1.f; Be = 0.f; }
                    const float At = __shfl(As, l15), Bt = __shfl(Bs, l15);
                    float h = Ae * H + Be; H = At * H + Bt; Ptot *= At;
#pragma unroll
                    for (int i = 3; i >= 0; --i) { h = av[mt][i] * h + bv[mt][i]; hsum[mt][i] += h; }
                }
            }
            if (PASS == 0) { if (quad == 0) AGG[(size_t)(c * 2 + dir) * DM + ch] = (f32x2){Ptot, H}; }
        }
        if (PASS == 1) {
            __syncthreads();
#pragma unroll
            for (int mt = 0; mt < 4; ++mt)
#pragma unroll
                for (int i = 0; i < 4; ++i) xcf[(16 * mt + 4 * quad + i) * XCF_STRIDE + chl] = hsum[mt][i];
            __syncthreads();
#pragma unroll
            for (int k = 0; k < 2; ++k) { const int item = tid + 512 * k, tt = item >> 4, cc = item & 15;
                const f32x4 h0 = *(const LAS f32x4*)(xcf + tt * XCF_STRIDE + cc * 8), h1 = *(const LAS f32x4*)(xcf + tt * XCF_STRIDE + cc * 8 + 4);
                bf16_t* p = Z + (size_t)(t0 + tt) * NIN + C_GR + n * 128 + cc * 8;
                const u32x4 g = *(const u32x4*)p;
                u32x4 o; o.x = cvt_pk_bf16(h0[0] * silu(bf_lo(g.x)), h0[1] * silu(bf_hi(g.x))); o.y = cvt_pk_bf16(h0[2] * silu(bf_lo(g.y)), h0[3] * silu(bf_hi(g.y)));
                o.z = cvt_pk_bf16(h1[0] * silu(bf_lo(g.z)), h1[1] * silu(bf_hi(g.z))); o.w = cvt_pk_bf16(h1[2] * silu(bf_lo(g.w)), h1[3] * silu(bf_hi(g.w)));
                *(u32x4*)p = o; }
        }
        __syncthreads();
    }
}

__device__ __forceinline__ void carry_phase(LAS unsigned char* lds, const f32x2* __restrict__ AGG, float* __restrict__ CARRY, int S, int bid, int G) {
    int tid = threadIdx.x; asm volatile("" : "+v"(tid));
    const int NC = S >> 6, SEG = NC >> 4, seg = tid >> 5, cl = tid & 31;
    LAS f32x2* sagg = (LAS f32x2*)lds;
    for (int cb = bid; cb < (2 * DM) / 32; cb += G) {
        const int chain = cb * 32 + cl, dir = chain >> 11, ch = chain & (DM - 1);
        float Ae[16], Be[16]; float A = 1.f, B = 0.f;
#pragma unroll
        for (int k = 0; k < 16; ++k) { Ae[k] = A; Be[k] = B;
            if (k < SEG) { const int p = seg * SEG + k, c = dir ? (NC - 1 - p) : p; const f32x2 ab = AGG[(size_t)(c * 2 + dir) * DM + ch]; B = ab.x * B + ab.y; A = ab.x * A; } }
        sagg[seg * 32 + cl] = (f32x2){A, B};
        __syncthreads();
        float h = 0.f;
        for (int s2 = 0; s2 < seg; ++s2) { const f32x2 ab = sagg[s2 * 32 + cl]; h = ab.x * h + ab.y; }
#pragma unroll
        for (int k = 0; k < 16; ++k) if (k < SEG) { const int p = seg * SEG + k, c = dir ? (NC - 1 - p) : p; CARRY[(size_t)(c * 2 + dir) * DM + ch] = Ae[k] * h + Be[k]; }
        __syncthreads();
    }
}

__device__ __forceinline__ void ln_phase(float* io, bf16_t* xb, int S, const float* lng, const float* lnb, int bid, int G) {
    int tid = threadIdx.x; asm volatile("" : "+v"(tid));
    const int lane = tid & 63, gw = bid * 8 + (tid >> 6), NGW = G * 8;
    f32x4 gv[8], bv[8];
#pragma unroll
    for (int j = 0; j < 8; ++j) { gv[j] = ((const f32x4*)lng)[lane + 64 * j]; bv[j] = ((const f32x4*)lnb)[lane + 64 * j]; }
    for (int row = gw; row < S; row += NGW) {
        f32x4* p = (f32x4*)(io + (size_t)row * DM);
        f32x4 v[8]; float s = 0.f;
#pragma unroll
        for (int j = 0; j < 8; ++j) { v[j] = p[lane + 64 * j]; s += (v[j][0] + v[j][1]) + (v[j][2] + v[j][3]); }
#pragma unroll
        for (int o = 1; o < 64; o <<= 1) s += __shfl_xor(s, o);
        const float mean = s * (1.0f / DM); float q = 0.f;
#pragma unroll
        for (int j = 0; j < 8; ++j) { v[j] = v[j] - mean; q += (v[j][0] * v[j][0] + v[j][1] * v[j][1]) + (v[j][2] * v[j][2] + v[j][3] * v[j][3]); }
#pragma unroll
        for (int o = 1; o < 64; o <<= 1) q += __shfl_xor(q, o);
        const float rstd = 1.0f / sqrtf(q * (1.0f / DM) + LN_EPS);
#pragma unroll
        for (int j = 0; j < 8; ++j) { const f32x4 y = v[j] * rstd * gv[j] + bv[j]; p[lane + 64 * j] = y;
            if (xb) { u32x2 o2; o2.x = cvt_pk_bf16(y[0], y[1]); o2.y = cvt_pk_bf16(y[2], y[3]); ((u32x2*)(xb + (size_t)row * DM))[lane + 64 * j] = o2; } }
    }
}

struct Args { const float* in[15]; float* out; unsigned char* ws; };

__global__ void __launch_bounds__(512, 2) fwd_kernel(Args a) {
    extern __shared__ __attribute__((aligned(16))) unsigned char lds_raw[];
    LAS unsigned char* lds = (LAS unsigned char*)lds_raw;
    cg::grid_group grid = cg::this_grid();
    const int tid = threadIdx.x, lane = tid & 63, wave = __builtin_amdgcn_readfirstlane(tid >> 6);
    const int G = gridDim.x, bid = blockIdx.x;
    const int gw = bid * 8 + wave, NGW = G * 8;
    unsigned char* ws = a.ws;
    float* biasTab = (float*)(ws + WS_BIAS);
    bf16_t* WIN = (bf16_t*)(ws + WS_WIN); bf16_t* WA = (bf16_t*)(ws + WS_WA); bf16_t* WR = (bf16_t*)(ws + WS_WR); bf16_t* WO = (bf16_t*)(ws + WS_WO); bf16_t* LW = (bf16_t*)(ws + WS_LW);
    bf16_t* XB = (bf16_t*)(ws + WS_XB); bf16_t* Z = (bf16_t*)(ws + WS_Z);
    float* LSE = (float*)(ws + WS_LSE); f32x2* AGG = (f32x2*)(ws + WS_AGG); float* CARRY = (float*)(ws + WS_CARRY);

    {
        LAS float* scr = (LAS float*)(lds + wave * 16384);
        constexpr int I_IN = (DM / 64) * (NIN / 32), I_A = (512 / 64) * (DM / 32), I_R = (DM / 64) * (DM / 32), I_L = 2 * 4;
        constexpr int NITEMS = 2 * I_IN + 2 * I_A + 4 * I_R + 128 * I_L;
        for (int it = gw; it < NITEMS; it += NGW) {
            int r = it;
            if (r < 2 * I_IN) { const int l = r / I_IN; p0_transpose_item(a.in[2] + (size_t)l * DM * NIN, DM, NIN, WIN + (size_t)l * NIN * DM, scr, r % I_IN, lane); continue; } r -= 2 * I_IN;
            if (r < 2 * I_A) { const int l = r / I_A; p0_transpose_item(a.in[9] + (size_t)l * 512 * DM, 512, DM, WA + (size_t)l * DM * 512, scr, r % I_A, lane); continue; } r -= 2 * I_A;
            if (r < 2 * I_R) { const int l = r / I_R; p0_transpose_item(a.in[10] + (size_t)l * DM * DM, DM, DM, WR + (size_t)l * DM * DM, scr, r % I_R, lane); continue; } r -= 2 * I_R;
            if (r < 2 * I_R) { const int l = r / I_R; p0_transpose_item(a.in[11] + (size_t)l * DM * DM, DM, DM, WO + (size_t)l * DM * DM, scr, r % I_R, lane); continue; } r -= 2 * I_R;
            { const int mtx = r / I_L; p0_transpose_item(a.in[6] + (size_t)mtx * 16384, 128, 128, LW + (size_t)mtx * 16384, scr, r % I_L, lane); }
        }
        const int gt = bid * 512 + tid, GT = G * 512;
        for (int i = gt; i < NTOK * (DM / 8); i += GT) {
            const size_t e = (size_t)i * 8; const float* src = (e < (size_t)8192 * DM) ? (a.in[0] + e) : (a.in[1] + (e - (size_t)8192 * DM));
            const f32x4 x0 = *(const f32x4*)src, x1 = *(const f32x4*)(src + 4);
            u32x4 o; o.x = cvt_pk_bf16(x0[0], x0[1]); o.y = cvt_pk_bf16(x0[2], x0[3]); o.z = cvt_pk_bf16(x1[0], x1[1]); o.w = cvt_pk_bf16(x1[2], x1[3]);
            *(u32x4*)(XB + e) = o;
        }
        for (int i = gt; i < 12 * 129; i += GT) { const int hd = i / 129, k = i % 129; biasTab[i] = a.in[14][(int)T5B[hd >> 2][k] * 12 + hd] * LOG2E; }
    }
    grid.sync();

#pragma nounroll
    for (int step = 0; step < 6; ++step) {
        const int l = step / 3, b = step - 3 * l;
        const int S = (b == 0) ? 8192 : 16384; const int rowoff = (b == 0) ? 0 : 8192 + (b - 1) * 16384;
        float* outb = a.out + (size_t)rowoff * DM;
        { pg8::Gemm g{XB + (size_t)rowoff * DM, WIN + (size_t)l * NIN * DM, S, NIN, DM, DM}; pg8::StaticOrder so; so.init(S, NIN, G, bid);
          pg8::EpiIn E{Z, NIN, a.in[3] + (size_t)l * NIN}; pg8::gemm_phase<pg8::EpiIn>(lds, g, so, E); }
        grid.sync();
        attn_phase(lds, Z, S, LSE, biasTab, bid, G);
        lru_phase<0>(lds, Z, S, a.in[4] + (size_t)l * 4 * DM, a.in[5] + (size_t)l * DM, LW + (size_t)l * 64 * 16384, a.in[7] + (size_t)l * 64 * 128, a.in[8] + (size_t)l * 2 * DM, AGG, CARRY, bid, G);
        grid.sync();
        carry_phase(lds, AGG, CARRY, S, bid, G);
        grid.sync();
        lru_phase<1>(lds, Z, S, a.in[4] + (size_t)l * 4 * DM, a.in[5] + (size_t)l * DM, LW + (size_t)l * 64 * 16384, a.in[7] + (size_t)l * 64 * 128, a.in[8] + (size_t)l * 2 * DM, AGG, CARRY, bid, G);
        combine_phase(Z, S, LSE, bid, G);
        grid.sync();
        { pg8::Gemm g{Z + C_GA, WA + (size_t)l * DM * 512, S, DM, 512, NIN}; pg8::StaticOrder so; so.init(S, DM, G, bid);
          pg8::EpiGateA E{Z}; pg8::gemm_phase<pg8::EpiGateA>(lds, g, so, E); }
        { pg8::Gemm g{Z + C_GR, WR + (size_t)l * DM * DM, S, DM, DM, NIN}; pg8::StaticOrder so; so.init(S, DM, G, bid);
          pg8::EpiGateR E{Z}; pg8::gemm_phase<pg8::EpiGateR>(lds, g, so, E); }
        grid.sync();
        { const float* xin = (l == 0) ? ((b == 0) ? a.in[0] : a.in[1] + (size_t)(b - 1) * 16384 * DM) : outb;
          pg8::Gemm g{Z + C_M, WO + (size_t)l * DM * DM, S, DM, DM, NIN}; pg8::StaticOrder so; so.init(S, DM, G, bid);
          pg8::EpiRes E{xin, outb}; pg8::gemm_phase<pg8::EpiRes>(lds, g, so, E); }
        grid.sync();
        ln_phase(outb, (l == 0) ? (XB + (size_t)rowoff * DM) : (bf16_t*)nullptr, S, a.in[12] + (size_t)l * DM, a.in[13] + (size_t)l * DM, bid, G);
    }
}

extern "C" void kernel_launch(void* const* d_in, const int* in_sizes, int n_in, void* d_out, int out_size, void* d_ws, size_t ws_size, hipStream_t stream) {
    static int grid = 0;
    if (grid == 0) {
        if (n_in != 15 || out_size != NTOK * DM || ws_size < WS_END) { fprintf(stderr, "kernel_launch: unexpected shapes (n_in %d out %d ws %zu)\n", n_in, out_size, ws_size); grid = -1; return; }
        int dev = 0, cus = 0, per_cu = 0;
        (void)hipGetDevice(&dev);
        (void)hipDeviceGetAttribute(&cus, hipDeviceAttributeMultiprocessorCount, dev);
        (void)hipFuncSetAttribute((const void*)fwd_kernel, hipFuncAttributeMaxDynamicSharedMemorySize, LDS_BYTES);
        (void)hipOccupancyMaxActiveBlocksPerMultiprocessor(&per_cu, (const void*)fwd_kernel, 512, LDS_BYTES);
        if (per_cu < 1) per_cu = 1;
        grid = cus * per_cu;
    }
    if (grid < 0) return;
    Args a{};
    for (int i = 0; i < 15; ++i) a.in[i] = (const float*)d_in[i];
    a.out = (float*)d_out; a.ws = (unsigned char*)d_ws;
    void* args[] = {&a};
    hipError_t e = hipLaunchCooperativeKernel((const void*)fwd_kernel, dim3(grid), dim3(512), args, LDS_BYTES, stream);
    if (e != hipSuccess) fprintf(stderr, "cooperative launch failed: %s (grid %d)\n", hipGetErrorString(e), grid);
}
```

```cpp
#include <hip/hip_runtime.h>
#include <hip/hip_cooperative_groups.h>
#include <cstdio>
#include <cstdint>
namespace cg = cooperative_groups;

#define LAS __attribute__((address_space(3)))
typedef unsigned short bf16_t;
typedef short bf16x8 __attribute__((ext_vector_type(8)));
typedef short s16x4 __attribute__((ext_vector_type(4)));
typedef float f32x4 __attribute__((ext_vector_type(4)));
typedef float f32x2 __attribute__((ext_vector_type(2)));
typedef unsigned u32x4 __attribute__((ext_vector_type(4)));
typedef unsigned u32x2 __attribute__((ext_vector_type(2)));

constexpr int DM = 2048, NIN = 13312, NTOK = 40960;
constexpr int C_Q = 0, C_K = 1536, C_V = 3072, C_GA = 4608, C_XR = 5120, C_GR = 7168, C_GM = 9216;
constexpr int C_TA = 1536;
constexpr int C_M = C_XR;
constexpr float ALPHA = 1.4142135623730951f, LN_EPS = 1e-5f;
constexpr float LOG2E = 1.4426950408889634f, LN2 = 0.6931471805599453f;

constexpr size_t MiB = 1u << 20;
constexpr size_t WS_BIAS = 1 * MiB, WS_WIN = 2 * MiB, WS_WA = 106 * MiB, WS_WR = 110 * MiB, WS_WO = 126 * MiB, WS_LW = 142 * MiB,
                 WS_XB = 146 * MiB, WS_Z = 306 * MiB, WS_LSE = 722 * MiB, WS_AGG = 723 * MiB, WS_CARRY = 731 * MiB, WS_END = 735 * MiB;
constexpr int LDS_BYTES = 147456;

__device__ const unsigned char T5B[3][129] = {
{11,11,11,11,11,11,11,11,11,11,11,11,11,11,11,10,10,10,10,10,10,10,10,10,10,10,10,10,10,10,10,10,10,10,10,10,10,10,9,9,9,9,9,9,9,9,9,9,9,9,8,8,8,8,8,8,8,7,6,5,4,3,2,1,0,17,18,19,20,21,22,23,24,24,24,24,24,24,24,25,25,25,25,25,25,25,25,25,25,25,25,26,26,26,26,26,26,26,26,26,26,26,26,26,26,26,26,26,26,26,26,26,26,26,27,27,27,27,27,27,27,27,27,27,27,27,27,27,27},
{13,13,13,13,13,13,13,13,13,13,13,13,13,13,13,13,13,13,13,13,13,13,13,12,12,12,12,12,12,12,12,12,12,12,12,12,12,12,12,12,12,12,11,11,11,11,11,11,11,11,11,11,10,10,10,10,10,10,9,9,9,8,8,4,0,20,24,24,25,25,25,26,26,26,26,26,26,27,27,27,27,27,27,27,27,27,27,28,28,28,28,28,28,28,28,28,28,28,28,28,28,28,28,28,28,28,29,29,29,29,29,29,29,29,29,29,29,29,29,29,29,29,29,29,29,29,29,29,29},
{15,15,15,15,15,15,15,15,15,15,15,15,15,15,15,15,15,15,15,15,15,15,15,15,15,15,15,15,15,15,14,14,14,14,14,14,14,14,14,14,14,14,14,14,14,13,13,13,13,13,13,13,13,13,12,12,12,12,12,11,11,10,10,9,0,25,26,26,27,27,28,28,28,28,28,29,29,29,29,29,29,29,29,29,30,30,30,30,30,30,30,30,30,30,30,30,30,30,30,31,31,31,31,31,31,31,31,31,31,31,31,31,31,31,31,31,31,31,31,31,31,31,31,31,31,31,31,31,31}};

__device__ __forceinline__ unsigned cvt_pk_bf16(float lo, float hi) { unsigned r; asm volatile("v_cvt_pk_bf16_f32 %0, %1, %2" : "=v"(r) : "v"(lo), "v"(hi)); return r; }
__device__ __forceinline__ float bf_lo(unsigned u) { return __uint_as_float(u << 16); }
__device__ __forceinline__ float bf_hi(unsigned u) { return __uint_as_float(u & 0xffff0000u); }
__device__ __forceinline__ float bf1(bf16_t u) { return __uint_as_float(((unsigned)u) << 16); }
__device__ __forceinline__ float sigm(float x) { return __builtin_amdgcn_rcpf(1.0f + __expf(-x)); }
__device__ __forceinline__ float silu(float x) { return x * sigm(x); }

namespace pg8 {
constexpr int BM = 256, BK = 64, HALF = 128, HTB = HALF * BK * 2, STAGE_BYTES = 8 * HTB, NXCD = 8, WGM = 8;
__host__ __device__ __forceinline__ int lds_byte(int r, int c) { const int st = (r >> 4) * 2 + (c >> 5), rr = r & 15, cc = c & 31, ob = rr * 64 + cc * 2; return st * 1024 + (ob ^ (((ob >> 9) & 1) << 5)); }
__host__ __device__ __forceinline__ void stage_rc(int b, int& R, int& C) { const int st = b / 1024, sb = b % 1024, swz = sb ^ (((sb >> 9) & 1) << 5); R = (st >> 1) * 16 + swz / 64; C = (st & 1) * 32 + (swz % 64) / 2; }
__host__ __device__ __forceinline__ int perm32(int rho) { const int n = rho >> 4, i = rho & 15; return 8 * (i >> 2) + 4 * n + (i & 3); }

struct Unit { int pm, pn; };
struct Gemm { const bf16_t* A; const bf16_t* Bt; int M, N, K, lda; };

struct StaticOrder {
    int nM, nN, nwg, G, c;
    __host__ __device__ void init(int M, int N, int G_, int c_) { nM = M / BM; nN = N / BM; nwg = nM * nN; G = G_; c = c_; }
    __host__ __device__ bool next(int i, Unit& u) const {
        const long L = (long)i * G + c; if (L >= nwg) return false;
        int wgid = (int)L; { const int q = nwg / NXCD, r = nwg % NXCD, xcd = wgid % NXCD, off = wgid / NXCD; wgid = (xcd < r ? xcd * (q + 1) : r * (q + 1) + (xcd - r) * q) + off; }
        const int nig = WGM * nN, gid = wgid / nig, fm = gid * WGM, gsz = (nM - fm) < WGM ? (nM - fm) : WGM;
        u.pm = fm + ((wgid % nig) % gsz); u.pn = (wgid % nig) / gsz; return true;
    }
};

struct EpiIn {
    bf16_t* O; int ldc; const float* bias;
    __device__ __forceinline__ void operator()(const f32x4 (&acc)[2][2][4][2], const Unit& u, int wr, int wc, int fr, int fq) const {
        const int row0 = u.pm * BM + wr * 64 + fr; const int col0 = u.pn * BM + wc * 32 + 8 * fq;
        f32x4 bv[2][2];
#pragma unroll
        for (int bj = 0; bj < 2; ++bj)
#pragma unroll
            for (int n = 0; n < 2; ++n) bv[bj][n] = *(const f32x4*)(bias + col0 + bj * HALF + 4 * n);
#pragma unroll
        for (int ai = 0; ai < 2; ++ai)
#pragma unroll
            for (int m = 0; m < 4; ++m) { bf16_t* rowp = O + (size_t)(row0 + ai * HALF + m * 16) * ldc + col0;
#pragma unroll
                for (int bj = 0; bj < 2; ++bj) { const f32x4 v0 = acc[ai][bj][m][0] + bv[bj][0], v1 = acc[ai][bj][m][1] + bv[bj][1];
                    u32x4 w; w.x = cvt_pk_bf16(v0[0], v0[1]); w.y = cvt_pk_bf16(v0[2], v0[3]); w.z = cvt_pk_bf16(v1[0], v1[1]); w.w = cvt_pk_bf16(v1[2], v1[3]);
                    *(u32x4*)(rowp + bj * HALF) = w; } }
    }
};
struct EpiGateA {
    bf16_t* Z;
    __device__ __forceinline__ void operator()(const f32x4 (&acc)[2][2][4][2], const Unit& u, int wr, int wc, int fr, int fq) const {
        const int row0 = u.pm * BM + wr * 64 + fr; const int col0 = u.pn * BM + wc * 32 + 8 * fq;
#pragma unroll
        for (int ai = 0; ai < 2; ++ai)
#pragma unroll
            for (int m = 0; m < 4; ++m) { bf16_t* zr = Z + (size_t)(row0 + ai * HALF + m * 16) * NIN + col0;
#pragma unroll
                for (int bj = 0; bj < 2; ++bj) { const f32x4 v0 = acc[ai][bj][m][0], v1 = acc[ai][bj][m][1];
                    const u32x4 g = *(const u32x4*)(zr + C_GM + bj * HALF);
                    u32x4 w; w.x = cvt_pk_bf16(v0[0] * sigm(bf_lo(g.x)), v0[1] * sigm(bf_hi(g.x))); w.y = cvt_pk_bf16(v0[2] * sigm(bf_lo(g.y)), v0[3] * sigm(bf_hi(g.y)));
                    w.z = cvt_pk_bf16(v1[0] * sigm(bf_lo(g.z)), v1[1] * sigm(bf_hi(g.z))); w.w = cvt_pk_bf16(v1[2] * sigm(bf_lo(g.w)), v1[3] * sigm(bf_hi(g.w)));
                    *(u32x4*)(zr + C_TA + bj * HALF) = w; } }
    }
};
struct EpiGateR {
    bf16_t* Z;
    __device__ __forceinline__ void operator()(const f32x4 (&acc)[2][2][4][2], const Unit& u, int wr, int wc, int fr, int fq) const {
        const int row0 = u.pm * BM + wr * 64 + fr; const int col0 = u.pn * BM + wc * 32 + 8 * fq;
#pragma unroll
        for (int ai = 0; ai < 2; ++ai)
#pragma unroll
            for (int m = 0; m < 4; ++m) { bf16_t* zr = Z + (size_t)(row0 + ai * HALF + m * 16) * NIN + col0;
#pragma unroll
                for (int bj = 0; bj < 2; ++bj) { const f32x4 v0 = acc[ai][bj][m][0], v1 = acc[ai][bj][m][1];
                    const u32x4 g = *(const u32x4*)(zr + C_GM + DM + bj * HALF);
                    const u32x4 t = *(const u32x4*)(zr + C_TA + bj * HALF);
                    u32x4 w; w.x = cvt_pk_bf16(bf_lo(t.x) + v0[0] * sigm(bf_lo(g.x)), bf_hi(t.x) + v0[1] * sigm(bf_hi(g.x)));
                    w.y = cvt_pk_bf16(bf_lo(t.y) + v0[2] * sigm(bf_lo(g.y)), bf_hi(t.y) + v0[3] * sigm(bf_hi(g.y)));
                    w.z = cvt_pk_bf16(bf_lo(t.z) + v1[0] * sigm(bf_lo(g.z)), bf_hi(t.z) + v1[1] * sigm(bf_hi(g.z)));
                    w.w = cvt_pk_bf16(bf_lo(t.w) + v1[2] * sigm(bf_lo(g.w)), bf_hi(t.w) + v1[3] * sigm(bf_hi(g.w)));
                    *(u32x4*)(zr + C_M + bj * HALF) = w; } }
    }
};
struct EpiRes {
    const float* xin; float* out;
    __device__ __forceinline__ void operator()(const f32x4 (&acc)[2][2][4][2], const Unit& u, int wr, int wc, int fr, int fq) const {
        const int row0 = u.pm * BM + wr * 64 + fr; const int col0 = u.pn * BM + wc * 32 + 8 * fq;
#pragma unroll
        for (int ai = 0; ai < 2; ++ai)
#pragma unroll
            for (int m = 0; m < 4; ++m) { const size_t off = (size_t)(row0 + ai * HALF + m * 16) * DM + col0;
#pragma unroll
                for (int bj = 0; bj < 2; ++bj) {
                    const f32x4 x0 = *(const f32x4*)(xin + off + bj * HALF), x1 = *(const f32x4*)(xin + off + bj * HALF + 4);
                    const f32x4 o0 = x0 * ALPHA + acc[ai][bj][m][0], o1 = x1 * ALPHA + acc[ai][bj][m][1];
                    *(f32x4*)(out + off + bj * HALF) = o0; *(f32x4*)(out + off + bj * HALF + 4) = o1; } }
    }
};

template <class Epi>
__device__ __forceinline__ void gemm_phase(LAS unsigned char* lds, const Gemm g, const StaticOrder& S, const Epi& E) {
    int tid = threadIdx.x; asm volatile("" : "+v"(tid));
    const int wid = __builtin_amdgcn_readfirstlane(tid >> 6), lane = tid & 63, wr = wid >> 2, wc = wid & 3, fr = lane & 15, fq = lane >> 4;
    const int K = g.K, nt = K / BK, lda = g.lda;
    unsigned voffA[2], voffB[2];
#pragma unroll
    for (int i = 0; i < 2; ++i) { int R, C; stage_rc(tid * 16 + i * 8192, R, C); const int Rb = (R & ~31) + perm32(R & 31);
        voffA[i] = (unsigned)(R * lda + C) * 2u; voffB[i] = (unsigned)(Rb * K + C) * 2u; }
    const size_t kstep = (size_t)(BK * 2);
    const size_t hstepA = (size_t)HALF * lda * 2, hstepB = (size_t)HALF * K * 2;
    const size_t tstepA = 2 * hstepA, tstepB = 2 * hstepB;
    const unsigned ldsw = (unsigned)wid * 1024u;
    const int aoff = lds_byte(wr * 64 + fr, fq * 8), boff = lds_byte(wc * 32 + fr, fq * 8);
#define PG8_SA(b, h) (((b) * 2 + (h)) * HTB)
#define PG8_SB(b, h) ((4 + (b) * 2 + (h)) * HTB)
#define PG8_STAGE(bufoff, gbase, voff) do { _Pragma("unroll") for (int _i = 0; _i < 2; ++_i) \
        __builtin_amdgcn_global_load_lds((const unsigned*)((const char*)(gbase) + (voff)[_i]), (LAS unsigned*)(lds + (bufoff) + ldsw + _i * 8192), 16, 0, 0); } while (0)
#define PG8_LDA(dst, b, h) do { _Pragma("unroll") for (int m = 0; m < 4; ++m) _Pragma("unroll") for (int k = 0; k < 2; ++k) dst[m][k] = *(const LAS bf16x8*)(lds + PG8_SA(b, h) + aoff + m * 2048 + k * 1024); } while (0)
#define PG8_LDB(dst, b, h) do { _Pragma("unroll") for (int n = 0; n < 2; ++n) _Pragma("unroll") for (int k = 0; k < 2; ++k) dst[n][k] = *(const LAS bf16x8*)(lds + PG8_SB(b, h) + boff + n * 2048 + k * 1024); } while (0)
#define PG8_MMA(ai, bj, At, Bt) do { __builtin_amdgcn_s_setprio(1); _Pragma("unroll") for (int m = 0; m < 4; ++m) _Pragma("unroll") for (int n = 0; n < 2; ++n) _Pragma("unroll") for (int k = 0; k < 2; ++k) \
        acc[ai][bj][m][n] = __builtin_amdgcn_mfma_f32_16x16x32_bf16(Bt[n][k], At[m][k], acc[ai][bj][m][n], 0, 0, 0); __builtin_amdgcn_s_setprio(0); } while (0)
#define PG8_WAIT_V(n) asm volatile("s_waitcnt vmcnt(" #n ")" ::: "memory")
#define PG8_WAIT_L(n) asm volatile("s_waitcnt lgkmcnt(" #n ")" ::: "memory")
#define PG8_BAR __builtin_amdgcn_s_barrier()
#define PG8_SCHED __builtin_amdgcn_sched_barrier(0)
    Unit cur, nxt; int ui = 0;
    if (!S.next(0, cur)) return;
    f32x4 acc[2][2][4][2];
#pragma unroll
    for (int a = 0; a < 2; ++a)
#pragma unroll
        for (int b = 0; b < 2; ++b)
#pragma unroll
            for (int m = 0; m < 4; ++m)
#pragma unroll
                for (int n = 0; n < 2; ++n) acc[a][b][m][n] = (f32x4){0.f, 0.f, 0.f, 0.f};
    bf16x8 At[4][2], B0[2][2], B1[2][2];
    const char* cA = (const char*)g.A + (size_t)cur.pm * tstepA; const char* cB = (const char*)g.Bt + (size_t)cur.pn * tstepB;
    PG8_STAGE(PG8_SB(0, 0), cB, voffB); PG8_STAGE(PG8_SB(0, 1), cB + hstepB, voffB); PG8_STAGE(PG8_SA(0, 0), cA, voffA); PG8_STAGE(PG8_SA(0, 1), cA + hstepA, voffA);
    if (wr == 1) PG8_BAR;
    PG8_WAIT_V(2); PG8_BAR;
    PG8_STAGE(PG8_SB(1, 0), cB + kstep, voffB); PG8_STAGE(PG8_SA(1, 0), cA + kstep, voffA); PG8_STAGE(PG8_SB(1, 1), cB + hstepB + kstep, voffB);
    PG8_WAIT_V(6); PG8_BAR;
    for (;;) {
        const bool has_next = S.next(ui + 1, nxt);
        const char* nA = has_next ? (const char*)g.A + (size_t)nxt.pm * tstepA : cA; const char* nB = has_next ? (const char*)g.Bt + (size_t)nxt.pn * tstepB : cB;
        for (int t = 0; t < nt; t += 2) {
            const bool last = (t == nt - 2);
            const char* a1 = cA + (size_t)(t + 1) * kstep;
            const char* a2 = last ? nA : cA + (size_t)(t + 2) * kstep; const char* b2 = last ? nB : cB + (size_t)(t + 2) * kstep;
            const char* a3 = a2 + kstep; const char* b3 = b2 + kstep;
            PG8_LDB(B0, 0, 0); PG8_LDB(B1, 0, 1); PG8_SCHED; PG8_LDA(At, 0, 0); PG8_STAGE(PG8_SA(1, 1), a1 + hstepA, voffA);
            PG8_WAIT_V(8); PG8_WAIT_L(0); PG8_BAR; PG8_MMA(0, 0, At, B0); PG8_MMA(0, 1, At, B1); PG8_BAR; PG8_SCHED;
            PG8_LDA(At, 0, 1); PG8_STAGE(PG8_SB(0, 0), b2, voffB); PG8_STAGE(PG8_SB(0, 1), b2 + hstepB, voffB); PG8_STAGE(PG8_SA(0, 0), a2, voffA);
            PG8_WAIT_V(8); PG8_WAIT_L(0); PG8_BAR; PG8_MMA(1, 0, At, B0); PG8_MMA(1, 1, At, B1); PG8_BAR; PG8_SCHED;
            PG8_LDB(B0, 1, 0); PG8_LDB(B1, 1, 1); PG8_SCHED; PG8_LDA(At, 1, 0); PG8_STAGE(PG8_SA(0, 1), a2 + hstepA, voffA);
            PG8_WAIT_V(8); PG8_WAIT_L(0); PG8_BAR; PG8_MMA(0, 0, At, B0); PG8_MMA(0, 1, At, B1); PG8_BAR; PG8_SCHED;
            PG8_LDA(At, 1, 1); PG8_STAGE(PG8_SB(1, 0), b3, voffB); PG8_STAGE(PG8_SB(1, 1), b3 + hstepB, voffB); PG8_STAGE(PG8_SA(1, 0), a3, voffA);
            PG8_WAIT_V(8); PG8_WAIT_L(0); PG8_BAR; PG8_MMA(1, 0, At, B0); PG8_MMA(1, 1, At, B1); PG8_BAR; PG8_SCHED;
        }
        if (wr == 0) PG8_BAR;
        E(acc, cur, wr, wc, fr, fq);
        if (!has_next) break;
#pragma unroll
        for (int a = 0; a < 2; ++a)
#pragma unroll
            for (int b = 0; b < 2; ++b)
#pragma unroll
                for (int m = 0; m < 4; ++m)
#pragma unroll
                    for (int n = 0; n < 2; ++n) acc[a][b][m][n] = (f32x4){0.f, 0.f, 0.f, 0.f};
        cur = nxt; cA = nA; cB = nB; ++ui;
        if (wr == 1) PG8_BAR;
    }
    PG8_WAIT_V(0);
    PG8_BAR;
#undef PG8_SA
#undef PG8_SB
#undef PG8_STAGE
#undef PG8_LDA
#undef PG8_LDB
#undef PG8_MMA
#undef PG8_WAIT_V
#undef PG8_WAIT_L
#undef PG8_BAR
#undef PG8_SCHED
}
}

__device__ __forceinline__ unsigned f2bf(float f) { unsigned u = __builtin_bit_cast(unsigned, f); return (u + 0x7fffu + ((u >> 16) & 1u)) >> 16; }
__device__ __forceinline__ unsigned pk2(float lo, float hi) { return f2bf(lo) | (f2bf(hi) << 16); }
__device__ __forceinline__ void p0_transpose_item(const float* W, int K, int N, bf16_t* WT, LAS float* scr, int item, int lane) {
    const int nblk = N / 32, kb = item / nblk, nb = item % nblk, k0 = 64 * kb, n0 = 32 * nb;
#pragma unroll 8
    for (int i = 0; i < 32; ++i) { const int kk = 2 * i + (lane >> 5); scr[kk * 33 + (lane & 31)] = W[(size_t)(k0 + kk) * N + n0 + (lane & 31)]; }
    asm volatile("s_waitcnt lgkmcnt(0)" ::: "memory");
    const int c = lane & 7;
#pragma unroll
    for (int j = 0; j < 4; ++j) { const int n = (lane >> 3) + 8 * j; const LAS float* s = scr + (8 * c) * 33 + n;
        u32x4 o; o.x = pk2(s[0 * 33], s[1 * 33]); o.y = pk2(s[2 * 33], s[3 * 33]); o.z = pk2(s[4 * 33], s[5 * 33]); o.w = pk2(s[6 * 33], s[7 * 33]);
        *(u32x4*)(WT + (size_t)(n0 + n) * K + k0 + 8 * c) = o; }
    asm volatile("s_waitcnt lgkmcnt(0)" ::: "memory");
}

constexpr int KVS = 272;
constexpr int LDS_K = 0, LDS_V = 256 * KVS, LDS_SB = 2 * 256 * KVS;
__device__ __forceinline__ void attn_phase(LAS unsigned char* lds, bf16_t* Z, int S, float* lse, const float* biasTab, int bid, int G) {
    int tid = threadIdx.x; asm volatile("" : "+v"(tid));
    const int lane = tid & 63, w = __builtin_amdgcn_readfirstlane(tid >> 6), l15 = lane & 15, quad = lane >> 4;
    const int nunits = 12 * (S >> 7);
    for (int u = bid; u < nunits; u += G) {
        const int hd = u % 12, rest = u / 12, g = hd >> 2, dsh = 2 * g;
        const int Lsub = S >> dsh, cpr = Lsub >> 7, r = rest / cpr, jc = rest - r * cpr, j0 = jc << 7;
        {
            const int c = tid & 15, rbase = tid >> 4;
            u32x4 kk[8], vv[8];
#pragma unroll
            for (int it = 0; it < 8; ++it) { const int i = rbase + 32 * it, j = j0 - 64 + i; const bool ok = (j >= 0) && (j < Lsub);
                const int jcl = ok ? j : 0; const bf16_t* p = Z + ((size_t)((jcl << dsh) + r)) * NIN + hd * 128 + c * 8;
                u32x4 a = *(const u32x4*)(p + C_K), b = *(const u32x4*)(p + C_V);
                if (!ok) { a = (u32x4){0u, 0u, 0u, 0u}; b = a; }
                kk[it] = a; vv[it] = b; }
#pragma unroll
            for (int it = 0; it < 8; ++it) { const int i = rbase + 32 * it;
                *(LAS u32x4*)(lds + LDS_K + i * KVS + c * 16) = kk[it]; *(LAS u32x4*)(lds + LDS_V + i * KVS + c * 16) = vv[it]; }
            if (tid < 129) ((LAS float*)(lds + LDS_SB))[tid] = biasTab[hd * 129 + tid];
        }
        const int jq = j0 + 16 * w + l15; const size_t tokq = ((size_t)jq << dsh) + r;
        bf16_t* qrow = Z + tokq * NIN + hd * 128;
        bf16x8 qf[4];
#pragma unroll
        for (int ks = 0; ks < 4; ++ks) qf[ks] = *(const bf16x8*)(qrow + ks * 32 + quad * 8);
        __syncthreads();
        f32x4 sacc[9];
        const LAS unsigned char* kbase = lds + LDS_K + (16 * w + l15) * KVS + quad * 16;
#pragma unroll
        for (int kt = 0; kt < 9; ++kt) { f32x4 a4 = (f32x4){0.f, 0.f, 0.f, 0.f};
#pragma unroll
            for (int ks = 0; ks < 4; ++ks) { const bf16x8 a = *(const LAS bf16x8*)(kbase + kt * 16 * KVS + ks * 64); a4 = __builtin_amdgcn_mfma_f32_16x16x32_bf16(a, qf[ks], a4, 0, 0, 0); }
            sacc[kt] = a4; }
        const float sc = 0.08838834764831845f * LOG2E;
        const LAS float* sb = (const LAS float*)(lds + LDS_SB);
        float mx = -1e30f;
#pragma unroll
        for (int kt = 0; kt < 9; ++kt)
#pragma unroll
            for (int i = 0; i < 4; ++i) { const int c = 16 * kt + 4 * quad + i, o64 = c - l15, jk = j0 + 16 * w - 64 + c;
                const bool valid = (o64 >= 0) && (o64 <= 128) && (jk >= 0) && (jk < Lsub);
                const int oc = o64 < 0 ? 0 : (o64 > 128 ? 128 : o64);
                const float s = valid ? (sacc[kt][i] * sc + sb[oc]) : -1e30f;
                sacc[kt][i] = s; mx = fmaxf(mx, s); }
        mx = fmaxf(mx, __shfl_xor(mx, 16)); mx = fmaxf(mx, __shfl_xor(mx, 32));
        float den = 0.f;
#pragma unroll
        for (int kt = 0; kt < 9; ++kt)
#pragma unroll
            for (int i = 0; i < 4; ++i) { const float p = __builtin_amdgcn_exp2f(sacc[kt][i] - mx); sacc[kt][i] = p; den += p; }
        den += __shfl_xor(den, 16); den += __shfl_xor(den, 32);
        bf16x8 pb[5];
#pragma unroll
        for (int s = 0; s < 5; ++s) { const f32x4 lo = sacc[2 * s]; const f32x4 hi = (2 * s + 1 < 9) ? sacc[(2 * s + 1 < 9) ? 2 * s + 1 : 8] : (f32x4){0.f, 0.f, 0.f, 0.f};
            u32x4 pk; pk.x = cvt_pk_bf16(lo[0], lo[1]); pk.y = cvt_pk_bf16(lo[2], lo[3]); pk.z = cvt_pk_bf16(hi[0], hi[1]); pk.w = cvt_pk_bf16(hi[2], hi[3]);
            pb[s] = __builtin_bit_cast(bf16x8, pk); }
        f32x4 oacc[8];
        const LAS unsigned char* vbase = lds + LDS_V + (16 * w + 4 * quad + (l15 >> 2)) * KVS + (l15 & 3) * 8;
#pragma unroll
        for (int dt = 0; dt < 8; ++dt) { f32x4 o4 = (f32x4){0.f, 0.f, 0.f, 0.f};
#pragma unroll
            for (int s = 0; s < 5; ++s) {
                const s16x4 lo = __builtin_bit_cast(s16x4, __builtin_amdgcn_ds_read_tr16_b64_v4i16((LAS s16x4*)(vbase + (s * 32) * KVS + dt * 32)));
                s16x4 hi = (s16x4){0, 0, 0, 0};
                if (s < 4) hi = __builtin_bit_cast(s16x4, __builtin_amdgcn_ds_read_tr16_b64_v4i16((LAS s16x4*)(vbase + (s * 32 + 16) * KVS + dt * 32)));
                const bf16x8 a = (bf16x8){lo[0], lo[1], lo[2], lo[3], hi[0], hi[1], hi[2], hi[3]};
                o4 = __builtin_amdgcn_mfma_f32_16x16x32_bf16(a, pb[s], o4, 0, 0, 0); }
            oacc[dt] = o4; }
        const float inv = 1.0f / den;
#pragma unroll
        for (int dt = 0; dt < 8; ++dt) { u32x2 o2; o2.x = cvt_pk_bf16(oacc[dt][0] * inv, oacc[dt][1] * inv); o2.y = cvt_pk_bf16(oacc[dt][2] * inv, oacc[dt][3] * inv);
            *(u32x2*)(qrow + 16 * dt + 4 * quad) = o2; }
        if (quad == 0) lse[tokq * 12 + hd] = (mx + __log2f(den)) * LN2;
        __syncthreads();
    }
}

__device__ __forceinline__ void combine_phase(bf16_t* Z, int S, const float* lse, int bid, int G) {
    int tid = threadIdx.x; asm volatile("" : "+v"(tid));
    const int lane = tid & 63, gw = bid * 8 + (tid >> 6), NGW = G * 8;
    const int h = lane >> 4, dc = lane & 15;
    for (int row = gw; row < S; row += NGW) {
        bf16_t* zr = Z + (size_t)row * NIN;
        const float l0 = lse[(size_t)row * 12 + h], l1 = lse[(size_t)row * 12 + 4 + h], l2 = lse[(size_t)row * 12 + 8 + h];
        const float m = fmaxf(l0, fmaxf(l1, l2));
        float e0 = __expf(l0 - m), e1 = __expf(l1 - m), e2 = __expf(l2 - m); const float inv = 1.0f / (e0 + e1 + e2); e0 *= inv; e1 *= inv; e2 *= inv;
        const u32x4 a = *(const u32x4*)(zr + (0 + h) * 128 + dc * 8), b = *(const u32x4*)(zr + (4 + h) * 128 + dc * 8), c = *(const u32x4*)(zr + (8 + h) * 128 + dc * 8);
        const u32x4 ga = *(const u32x4*)(zr + C_GA + h * 128 + dc * 8);
        u32x4 o;
#define CMB(f) o.f = cvt_pk_bf16((e0 * bf_lo(a.f) + e1 * bf_lo(b.f) + e2 * bf_lo(c.f)) * silu(bf_lo(ga.f)), (e0 * bf_hi(a.f) + e1 * bf_hi(b.f) + e2 * bf_hi(c.f)) * silu(bf_hi(ga.f)))
        CMB(x); CMB(y); CMB(z); CMB(w);
#undef CMB
        *(u32x4*)(zr + C_GA + h * 128 + dc * 8) = o;
    }
}

constexpr int XCF_STRIDE = 132, LDS_XCF = 0, LDS_XCB = 64 * XCF_STRIDE * 4, LDS_CW = LDS_XCB + 64 * KVS;
__device__ __forceinline__ float sigm2(float x) { return __builtin_amdgcn_rcpf(1.0f + __builtin_amdgcn_exp2f(x * -LOG2E)); }
template <int PASS>
__device__ __forceinline__ void lru_phase(LAS unsigned char* lds, bf16_t* Z, int S, const float* convw, const float* convb, const bf16_t* LWt, const float* lrub, const float* lam,
                                          f32x2* __restrict__ AGG, const float* __restrict__ CARRY, int bid, int G) {
    int tid = threadIdx.x; asm volatile("" : "+v"(tid));
    const int lane = tid & 63, w = __builtin_amdgcn_readfirstlane(tid >> 6), l15 = lane & 15, quad = lane >> 4;
    LAS float* xcf = (LAS float*)(lds + LDS_XCF);
    LAS float* cw = (LAS float*)(lds + LDS_CW);
    const int nb16 = G >> 4, n = bid & 15, cfirst = bid >> 4, NC = S >> 6;
    if (cfirst >= nb16) return;
    const int chl = 16 * w + l15, ch = n * 128 + chl;
    for (int i = tid; i < 5 * 128; i += 512) { const int j = i >> 7, ci = i & 127; cw[i] = (j < 4) ? convw[j * DM + n * 128 + ci] : convb[n * 128 + ci]; }
    bf16x8 bw[2][2][4]; float br[2], bi[2], k8[2];
#pragma unroll
    for (int dir = 0; dir < 2; ++dir) {
#pragma unroll
        for (int gt = 0; gt < 2; ++gt)
#pragma unroll
            for (int ks = 0; ks < 4; ++ks) bw[dir][gt][ks] = *(const bf16x8*)(LWt + ((size_t)(((dir * 2 + gt) * 16 + n) * 128 + chl)) * 128 + ks * 32 + quad * 8);
        br[dir] = lrub[((dir * 2 + 0) * 16 + n) * 128 + chl]; bi[dir] = lrub[((dir * 2 + 1) * 16 + n) * 128 + chl];
        k8[dir] = -8.0f * LOG2E * log1pf(__expf(-lam[dir * DM + ch]));
    }
    __syncthreads();
    for (int c = cfirst; c < NC; c += nb16) {
        const int t0 = c * 64;
#pragma unroll
        for (int k = 0; k < 2; ++k) { const int item = tid + 512 * k, tt = item >> 4, cc = item & 15;
            f32x4 x0 = *(const LAS f32x4*)(cw + 4 * 128 + cc * 8), x1 = *(const LAS f32x4*)(cw + 4 * 128 + cc * 8 + 4);
#pragma unroll
            for (int j = 0; j < 4; ++j) { const int row = t0 + tt + j - 2;
                if (row >= 0 && row < S) { const u32x4 x = *(const u32x4*)(Z + (size_t)row * NIN + C_XR + n * 128 + cc * 8);
                    const f32x4 w0 = *(const LAS f32x4*)(cw + j * 128 + cc * 8), w1 = *(const LAS f32x4*)(cw + j * 128 + cc * 8 + 4);
                    x0[0] += bf_lo(x.x) * w0[0]; x0[1] += bf_hi(x.x) * w0[1]; x0[2] += bf_lo(x.y) * w0[2]; x0[3] += bf_hi(x.y) * w0[3];
                    x1[0] += bf_lo(x.z) * w1[0]; x1[1] += bf_hi(x.z) * w1[1]; x1[2] += bf_lo(x.w) * w1[2]; x1[3] += bf_hi(x.w) * w1[3]; } }
            *(LAS f32x4*)(xcf + tt * XCF_STRIDE + cc * 8) = x0; *(LAS f32x4*)(xcf + tt * XCF_STRIDE + cc * 8 + 4) = x1;
            u32x4 pk; pk.x = cvt_pk_bf16(x0[0], x0[1]); pk.y = cvt_pk_bf16(x0[2], x0[3]); pk.z = cvt_pk_bf16(x1[0], x1[1]); pk.w = cvt_pk_bf16(x1[2], x1[3]);
            *(LAS u32x4*)(lds + LDS_XCB + tt * KVS + cc * 16) = pk; }
        __syncthreads();
        float hsum[4][4];
#pragma unroll
        for (int dir = 0; dir < 2; ++dir) {
            f32x4 ga[2][4];
#pragma unroll
            for (int mt = 0; mt < 4; ++mt) { ga[0][mt] = (f32x4){0.f, 0.f, 0.f, 0.f}; ga[1][mt] = (f32x4){0.f, 0.f, 0.f, 0.f};
#pragma unroll
                for (int ks = 0; ks < 4; ++ks) { const bf16x8 a = *(const LAS bf16x8*)(lds + LDS_XCB + (16 * mt + l15) * KVS + ks * 64 + quad * 16);
                    ga[0][mt] = __builtin_amdgcn_mfma_f32_16x16x32_bf16(a, bw[dir][0][ks], ga[0][mt], 0, 0, 0);
                    ga[1][mt] = __builtin_amdgcn_mfma_f32_16x16x32_bf16(a, bw[dir][1][ks], ga[1][mt], 0, 0, 0); } }
            float av[4][4], bv[4][4];
#pragma unroll
            for (int mt = 0; mt < 4; ++mt)
#pragma unroll
                for (int i = 0; i < 4; ++i) { const float rg = sigm2(ga[0][mt][i] + br[dir]), ig = sigm2(ga[1][mt][i] + bi[dir]);
                    const float xcv = xcf[(16 * mt + 4 * quad + i) * XCF_STRIDE + chl];
                    const float av_ = __builtin_amdgcn_exp2f(k8[dir] * rg);
                    av[mt][i] = av_; bv[mt][i] = __builtin_amdgcn_sqrtf(fmaxf(1.0f - av_ * av_, 0.f)) * (ig * xcv); }
            float H = 0.f, Ptot = 1.f;
            if (PASS == 1) H = CARRY[(size_t)(c * 2 + dir) * DM + ch];
            if (dir == 0) {
#pragma unroll
                for (int mt = 0; mt < 4; ++mt) {
                    float As = av[mt][0] * av[mt][1] * av[mt][2] * av[mt][3];
                    float Bs = ((bv[mt][0] * av[mt][1] + bv[mt][1]) * av[mt][2] + bv[mt][2]) * av[mt][3] + bv[mt][3];
                    float Ap = __shfl_up(As, 16), Bp = __shfl_up(Bs, 16); if (quad >= 1) { Bs = As * Bp + Bs; As = Ap * As; }
                    Ap = __shfl_up(As, 32); Bp = __shfl_up(Bs, 32); if (quad >= 2) { Bs = As * Bp + Bs; As = Ap * As; }
                    float Ae = __shfl_up(As, 16), Be = __shfl_up(Bs, 16); if (quad == 0) { Ae = 1.f; Be = 0.f; }
                    const float At = __shfl(As, 48 + l15), Bt = __shfl(Bs, 48 + l15);
                    float h = Ae * H + Be; H = At * H + Bt; Ptot *= At;
#pragma unroll
                    for (int i = 0; i < 4; ++i) { h = av[mt][i] * h + bv[mt][i]; hsum[mt][i] = h; }
                }
            } else {
#pragma unroll
                for (int mt = 3; mt >= 0; --mt) {
                    float As = av[mt][3] * av[mt][2] * av[mt][1] * av[mt][0];
                    float Bs = ((bv[mt][3] * av[mt][2] + bv[mt][2]) * av[mt][1] + bv[mt][1]) * av[mt][0] + bv[mt][0];
                    float Ap = __shfl_down(As, 16), Bp = __shfl_down(Bs, 16); if (quad <= 2) { Bs = As * Bp + Bs; As = Ap * As; }
                    Ap = __shfl_down(As, 32); Bp = __shfl_down(Bs, 32); if (quad <= 1) { Bs = As * Bp + Bs; As = Ap * As; }
                    float Ae = __shfl_down(As, 16), Be = __shfl_down(Bs, 16); if (quad == 3) { Ae = 1.f; Be = 0.f; }
                    const float At = __shfl(As, l15), Bt = __shfl(Bs, l15);
                    float h = Ae * H + Be; H = At * H + Bt; Ptot *= At;
#pragma unroll
                    for (int i = 3; i >= 0; --i) { h = av[mt][i] * h + bv[mt][i]; hsum[mt][i] += h; }
                }
            }
            if (PASS == 0) { if (quad == 0) AGG[(size_t)(c * 2 + dir) * DM + ch] = (f32x2){Ptot, H}; }
        }
        if (PASS == 1) {
            __syncthreads();
#pragma unroll
            for (int mt = 0; mt < 4; ++mt)
#pragma unroll
                for (int i = 0; i < 4; ++i) xcf[(16 * mt + 4 * quad + i) * XCF_STRIDE + chl] = hsum[mt][i];
            __syncthreads();
#pragma unroll
            for (int k = 0; k < 2; ++k) { const int item = tid + 512 * k, tt = item >> 4, cc = item & 15;
                const f32x4 h0 = *(const LAS f32x4*)(xcf + tt * XCF_STRIDE + cc * 8), h1 = *(const LAS f32x4*)(xcf + tt * XCF_STRIDE + cc * 8 + 4);
                bf16_t* p = Z + (size_t)(t0 + tt) * NIN + C_GR + n * 128 + cc * 8;
                const u32x4 g = *(const u32x4*)p;
                u32x4 o; o.x = cvt_pk_bf16(h0[0] * silu(bf_lo(g.x)), h0[1] * silu(bf_hi(g.x))); o.y = cvt_pk_bf16(h0[2] * silu(bf_lo(g.y)), h0[3] * silu(bf_hi(g.y)));
                o.z = cvt_pk_bf16(h1[0] * silu(bf_lo(g.z)), h1[1] * silu(bf_hi(g.z))); o.w = cvt_pk_bf16(h1[2] * silu(bf_lo(g.w)), h1[3] * silu(bf_hi(g.w)));
                *(u32x4*)p = o; }
        }
        __syncthreads();
    }
}

__device__ __forceinline__ void carry_phase(LAS unsigned char* lds, const f32x2* __restrict__ AGG, float* __restrict__ CARRY, int S, int bid, int G) {
    int tid = threadIdx.x; asm volatile("" : "+v"(tid));
    const int NC = S >> 6, SEG = NC >> 4, seg = tid >> 5, cl = tid & 31;
    LAS f32x2* sagg = (LAS f32x2*)lds;
    for (int cb = bid; cb < (2 * DM) / 32; cb += G) {
        const int chain = cb * 32 + cl, dir = chain >> 11, ch = chain & (DM - 1);
        float Ae[16], Be[16]; float A = 1.f, B = 0.f;
#pragma unroll
        for (int k = 0; k < 16; ++k) { Ae[k] = A; Be[k] = B;
            if (k < SEG) { const int p = seg * SEG + k, c = dir ? (NC - 1 - p) : p; const f32x2 ab = AGG[(size_t)(c * 2 + dir) * DM + ch]; B = ab.x * B + ab.y; A = ab.x * A; } }
        sagg[seg * 32 + cl] = (f32x2){A, B};
        __syncthreads();
        float h = 0.f;
        for (int s2 = 0; s2 < seg; ++s2) { const f32x2 ab = sagg[s2 * 32 + cl]; h = ab.x * h + ab.y; }
#pragma unroll
        for (int k = 0; k < 16; ++k) if (k < SEG) { const int p = seg * SEG + k, c = dir ? (NC - 1 - p) : p; CARRY[(size_t)(c * 2 + dir) * DM + ch] = Ae[k] * h + Be[k]; }
        __syncthreads();
    }
}

__device__ __forceinline__ void ln_phase(float* io, bf16_t* xb, int S, const float* lng, const float* lnb, int bid, int G) {
    int tid = threadIdx.x; asm volatile("" : "+v"(tid));
    const int lane = tid & 63, gw = bid * 8 + (tid >> 6), NGW = G * 8;
    f32x4 gv[8], bv[8];
#pragma unroll
    for (int j = 0; j < 8; ++j) { gv[j] = ((const f32x4*)lng)[lane + 64 * j]; bv[j] = ((const f32x4*)lnb)[lane + 64 * j]; }
    for (int row = gw; row < S; row += NGW) {
        f32x4* p = (f32x4*)(io + (size_t)row * DM);
        f32x4 v[8]; float s = 0.f;
#pragma unroll
        for (int j = 0; j < 8; ++j) { v[j] = p[lane + 64 * j]; s += (v[j][0] + v[j][1]) + (v[j][2] + v[j][3]); }
#pragma unroll
        for (int o = 1; o < 64; o <<= 1) s += __shfl_xor(s, o);
        const float mean = s * (1.0f / DM); float q = 0.f;
#pragma unroll
        for (int j = 0; j < 8; ++j) { v[j] = v[j] - mean; q += (v[j][0] * v[j][0] + v[j][1] * v[j][1]) + (v[j][2] * v[j][2] + v[j][3] * v[j][3]); }
#pragma unroll
        for (int o = 1; o < 64; o <<= 1) q += __shfl_xor(q, o);
        const float rstd = 1.0f / sqrtf(q * (1.0f / DM) + LN_EPS);
#pragma unroll
        for (int j = 0; j < 8; ++j) { const f32x4 y = v[j] * rstd * gv[j] + bv[j]; p[lane + 64 * j] = y;
            if (xb) { u32x2 o2; o2.x = cvt_pk_bf16(y[0], y[1]); o2.y = cvt_pk_bf16(y[2], y[3]); ((u32x2*)(xb + (size_t)row * DM))[lane + 64 * j] = o2; } }
    }
}


#define XB_TMO      128
#define XB_XCNT(j)  (256  + 64 * (j))
#define XB_XSUB(j)  (1280 + 64 * (j))
#define XB_XGEN(j)  (2304 + 64 * (j))
#define XB_TOP      3328
#define XB_TOPGEN   3392
#define XCD_BAR_WORDS 3456
#define XB_SPIN_CAP (1u << 22)
__device__ __forceinline__ unsigned xb_ld(unsigned* p)              { return __hip_atomic_load(p, __ATOMIC_RELAXED, __HIP_MEMORY_SCOPE_AGENT); }
__device__ __forceinline__ unsigned xb_add(unsigned* p, unsigned v) { return __hip_atomic_fetch_add(p, v, __ATOMIC_RELAXED, __HIP_MEMORY_SCOPE_AGENT); }
__device__ __forceinline__ unsigned xb_xcc_id() { return (unsigned)__builtin_amdgcn_s_getreg((3 << 11) | 20) & 0xFu; }
#define XB_SPIN(cond, bar) do { unsigned _sp = 0; while (cond) { __builtin_amdgcn_s_sleep(1); \
    if ((++_sp & 255u) == 0u) { if (xb_ld(&(bar)[XB_TMO])) break; if (_sp > XB_SPIN_CAP) { atomicAdd(&(bar)[XB_TMO], 1u); break; } } } } while (0)
struct XcdBarrier { unsigned* bar; unsigned x; volatile LAS unsigned* st; };
__device__ __forceinline__ XcdBarrier xcd_barrier_post(unsigned* bar, volatile LAS unsigned* st) {
    XcdBarrier b; b.bar = bar; b.x = xb_xcc_id(); b.st = st;
    if (threadIdx.x == 0) (void)xb_add(&bar[XB_XCNT(b.x)], 1u);
    return b;
}
__device__ __forceinline__ void xcd_barrier_complete(unsigned* bar, unsigned x, unsigned& nloc, unsigned& nx) {
    const unsigned G = gridDim.x * gridDim.y * gridDim.z;
    unsigned sum, cnt, mine, sp = 0u;
    for (;;) {
        sum = 0u; cnt = 0u; mine = 0u;
#pragma unroll
        for (unsigned j = 0; j < 16; ++j) { const unsigned c = xb_ld(&bar[XB_XCNT(j)]); sum += c; cnt += (c > 0u) ? 1u : 0u; mine = (j == x) ? c : mine; }
        if (sum == G) break;
        __builtin_amdgcn_s_sleep(1);
        if ((++sp & 255u) == 0u) { if (xb_ld(&bar[XB_TMO])) break; if (sp > XB_SPIN_CAP) { atomicAdd(&bar[XB_TMO], 1u); break; } }
    }
    nloc = mine > 0u ? mine : 1u; nx = cnt > 0u ? cnt : 1u;
}
__device__ __forceinline__ void xcd_barrier(const XcdBarrier& b) {
    asm volatile("s_waitcnt vmcnt(0)" ::: "memory");
    __syncthreads();
    if (threadIdx.x == 0) {
        unsigned* bar = b.bar;
        __builtin_amdgcn_s_waitcnt(0);
        unsigned nloc = b.st[0], nx = b.st[1];
        if (nloc == 0u) { xcd_barrier_complete(bar, b.x, nloc, nx); b.st[0] = nloc; b.st[1] = nx; }
        const unsigned old = xb_add(&bar[XB_XSUB(b.x)], 1u);
        const unsigned gen = old / nloc;
        if (old + 1u == (gen + 1u) * nloc) {
            __builtin_amdgcn_fence(__ATOMIC_RELEASE, "agent");
            asm volatile("s_waitcnt vmcnt(0)" ::: "memory");
            const unsigned og = xb_add(&bar[XB_TOP], 1u);
            const unsigned tg = og / nx;
            if (og + 1u == (tg + 1u) * nx) xb_add(&bar[XB_TOPGEN], 1u);
            else XB_SPIN(xb_ld(&bar[XB_TOPGEN]) == tg, bar);
            __builtin_amdgcn_fence(__ATOMIC_ACQUIRE, "agent");
            xb_add(&bar[XB_XGEN(b.x)], 1u);
            asm volatile("s_waitcnt vmcnt(0)" ::: "memory");
        } else {
            XB_SPIN(xb_ld(&bar[XB_XGEN(b.x)]) == gen, bar);
            __builtin_amdgcn_fence(__ATOMIC_ACQUIRE, "agent");
            asm volatile("s_waitcnt vmcnt(0)" ::: "memory");
        }
    }
    __syncthreads();
}

struct Args { const float* in[15]; float* out; unsigned char* ws; };

__global__ void __launch_bounds__(512, 2) fwd_kernel(Args a) {
    extern __shared__ __attribute__((aligned(16))) unsigned char lds_raw[];
    LAS unsigned char* lds = (LAS unsigned char*)lds_raw;
    cg::grid_group grid = cg::this_grid();
    const int tid = threadIdx.x, lane = tid & 63, wave = __builtin_amdgcn_readfirstlane(tid >> 6);
    const int G = gridDim.x, bid = blockIdx.x;
    const int gw = bid * 8 + wave, NGW = G * 8;
    unsigned char* ws = a.ws;
    float* biasTab = (float*)(ws + WS_BIAS);
    bf16_t* WIN = (bf16_t*)(ws + WS_WIN); bf16_t* WA = (bf16_t*)(ws + WS_WA); bf16_t* WR = (bf16_t*)(ws + WS_WR); bf16_t* WO = (bf16_t*)(ws + WS_WO); bf16_t* LW = (bf16_t*)(ws + WS_LW);
    bf16_t* XB = (bf16_t*)(ws + WS_XB); bf16_t* Z = (bf16_t*)(ws + WS_Z);
    float* LSE = (float*)(ws + WS_LSE); f32x2* AGG = (f32x2*)(ws + WS_AGG); float* CARRY = (float*)(ws + WS_CARRY);

    unsigned* barw = (unsigned*)ws;
    volatile LAS unsigned* bst = (volatile LAS unsigned*)(lds + LDS_BYTES - 64);
    if (bid == 0) { for (int i = tid; i < XCD_BAR_WORDS; i += 512) __hip_atomic_store(barw + i, 0u, __ATOMIC_RELAXED, __HIP_MEMORY_SCOPE_AGENT); }
    if (tid == 0) { bst[0] = 0u; bst[1] = 0u; }
    {
        LAS float* scr = (LAS float*)(lds + wave * 16384);
        constexpr int I_IN = (DM / 64) * (NIN / 32), I_A = (512 / 64) * (DM / 32), I_R = (DM / 64) * (DM / 32), I_L = 2 * 4;
        constexpr int NITEMS = 2 * I_IN + 2 * I_A + 4 * I_R + 128 * I_L;
        for (int it = gw; it < NITEMS; it += NGW) {
            int r = it;
            if (r < 2 * I_IN) { const int l = r / I_IN; p0_transpose_item(a.in[2] + (size_t)l * DM * NIN, DM, NIN, WIN + (size_t)l * NIN * DM, scr, r % I_IN, lane); continue; } r -= 2 * I_IN;
            if (r < 2 * I_A) { const int l = r / I_A; p0_transpose_item(a.in[9] + (size_t)l * 512 * DM, 512, DM, WA + (size_t)l * DM * 512, scr, r % I_A, lane); continue; } r -= 2 * I_A;
            if (r < 2 * I_R) { const int l = r / I_R; p0_transpose_item(a.in[10] + (size_t)l * DM * DM, DM, DM, WR + (size_t)l * DM * DM, scr, r % I_R, lane); continue; } r -= 2 * I_R;
            if (r < 2 * I_R) { const int l = r / I_R; p0_transpose_item(a.in[11] + (size_t)l * DM * DM, DM, DM, WO + (size_t)l * DM * DM, scr, r % I_R, lane); continue; } r -= 2 * I_R;
            { const int mtx = r / I_L; p0_transpose_item(a.in[6] + (size_t)mtx * 16384, 128, 128, LW + (size_t)mtx * 16384, scr, r % I_L, lane); }
        }
        const int gt = bid * 512 + tid, GT = G * 512;
        for (int i = gt; i < NTOK * (DM / 8); i += GT) {
            const size_t e = (size_t)i * 8; const float* src = (e < (size_t)8192 * DM) ? (a.in[0] + e) : (a.in[1] + (e - (size_t)8192 * DM));
            const f32x4 x0 = *(const f32x4*)src, x1 = *(const f32x4*)(src + 4);
            u32x4 o; o.x = cvt_pk_bf16(x0[0], x0[1]); o.y = cvt_pk_bf16(x0[2], x0[3]); o.z = cvt_pk_bf16(x1[0], x1[1]); o.w = cvt_pk_bf16(x1[2], x1[3]);
            *(u32x4*)(XB + e) = o;
        }
        for (int i = gt; i < 12 * 129; i += GT) { const int hd = i / 129, k = i % 129; biasTab[i] = a.in[14][(int)T5B[hd >> 2][k] * 12 + hd] * LOG2E; }
    }
    __threadfence();
    grid.sync();
    const XcdBarrier xbar = xcd_barrier_post(barw, bst);

#pragma nounroll
    for (int step = 0; step < 6; ++step) {
        const int l = step / 3, b = step - 3 * l;
        const int S = (b == 0) ? 8192 : 16384; const int rowoff = (b == 0) ? 0 : 8192 + (b - 1) * 16384;
        float* outb = a.out + (size_t)rowoff * DM;
        { pg8::Gemm g{XB + (size_t)rowoff * DM, WIN + (size_t)l * NIN * DM, S, NIN, DM, DM}; pg8::StaticOrder so; so.init(S, NIN, G, bid);
          pg8::EpiIn E{Z, NIN, a.in[3] + (size_t)l * NIN}; pg8::gemm_phase<pg8::EpiIn>(lds, g, so, E); }
        xcd_barrier(xbar);
        attn_phase(lds, Z, S, LSE, biasTab, bid, G);
        lru_phase<0>(lds, Z, S, a.in[4] + (size_t)l * 4 * DM, a.in[5] + (size_t)l * DM, LW + (size_t)l * 64 * 16384, a.in[7] + (size_t)l * 64 * 128, a.in[8] + (size_t)l * 2 * DM, AGG, CARRY, bid, G);
        xcd_barrier(xbar);
        carry_phase(lds, AGG, CARRY, S, bid, G);
        xcd_barrier(xbar);
        lru_phase<1>(lds, Z, S, a.in[4] + (size_t)l * 4 * DM, a.in[5] + (size_t)l * DM, LW + (size_t)l * 64 * 16384, a.in[7] + (size_t)l * 64 * 128, a.in[8] + (size_t)l * 2 * DM, AGG, CARRY, bid, G);
        combine_phase(Z, S, LSE, bid, G);
        xcd_barrier(xbar);
        { pg8::Gemm g{Z + C_GA, WA + (size_t)l * DM * 512, S, DM, 512, NIN}; pg8::StaticOrder so; so.init(S, DM, G, bid);
          pg8::EpiGateA E{Z}; pg8::gemm_phase<pg8::EpiGateA>(lds, g, so, E); }
        { pg8::Gemm g{Z + C_GR, WR + (size_t)l * DM * DM, S, DM, DM, NIN}; pg8::StaticOrder so; so.init(S, DM, G, bid);
          pg8::EpiGateR E{Z}; pg8::gemm_phase<pg8::EpiGateR>(lds, g, so, E); }
        xcd_barrier(xbar);
        { const float* xin = (l == 0) ? ((b == 0) ? a.in[0] : a.in[1] + (size_t)(b - 1) * 16384 * DM) : outb;
          pg8::Gemm g{Z + C_M, WO + (size_t)l * DM * DM, S, DM, DM, NIN}; pg8::StaticOrder so; so.init(S, DM, G, bid);
          pg8::EpiRes E{xin, outb}; pg8::gemm_phase<pg8::EpiRes>(lds, g, so, E); }
        xcd_barrier(xbar);
        ln_phase(outb, (l == 0) ? (XB + (size_t)rowoff * DM) : (bf16_t*)nullptr, S, a.in[12] + (size_t)l * DM, a.in[13] + (size_t)l * DM, bid, G);
    }
}

extern "C" void kernel_launch(void* const* d_in, const int* in_sizes, int n_in, void* d_out, int out_size, void* d_ws, size_t ws_size, hipStream_t stream) {
    static int grid = 0;
    if (grid == 0) {
        if (n_in != 15 || out_size != NTOK * DM || ws_size < WS_END) { fprintf(stderr, "kernel_launch: unexpected shapes (n_in %d out %d ws %zu)\n", n_in, out_size, ws_size); grid = -1; return; }
        int dev = 0, cus = 0, per_cu = 0;
        (void)hipGetDevice(&dev);
        (void)hipDeviceGetAttribute(&cus, hipDeviceAttributeMultiprocessorCount, dev);
        (void)hipFuncSetAttribute((const void*)fwd_kernel, hipFuncAttributeMaxDynamicSharedMemorySize, LDS_BYTES);
        (void)hipOccupancyMaxActiveBlocksPerMultiprocessor(&per_cu, (const void*)fwd_kernel, 512, LDS_BYTES);
        if (per_cu < 1) per_cu = 1;
        grid = cus * per_cu;
    }
    if (grid < 0) return;
    Args a{};
    for (int i = 0; i < 15; ++i) a.in[i] = (const float*)d_in[i];
    a.out = (float*)d_out; a.ws = (unsigned char*)d_ws;
    void* args[] = {&a};
    hipError_t e = hipLaunchCooperativeKernel((const void*)fwd_kernel, dim3(grid), dim3(512), args, LDS_BYTES, stream);
    if (e != hipSuccess) fprintf(stderr, "cooperative launch failed: %s (grid %d)\n", hipGetErrorString(e), grid);
}
```

```cpp
#include <hip/hip_runtime.h>
#include <hip/hip_cooperative_groups.h>
#include <cstdio>
#include <cstdint>
namespace cg = cooperative_groups;

#define LAS __attribute__((address_space(3)))
typedef unsigned short bf16_t;
typedef short bf16x8 __attribute__((ext_vector_type(8)));
typedef short s16x4 __attribute__((ext_vector_type(4)));
typedef float f32x4 __attribute__((ext_vector_type(4)));
typedef float f32x2 __attribute__((ext_vector_type(2)));
typedef unsigned u32x4 __attribute__((ext_vector_type(4)));
typedef unsigned u32x2 __attribute__((ext_vector_type(2)));

constexpr int DM = 2048, NIN = 13312, NTOK = 40960;
constexpr int C_Q = 0, C_K = 1536, C_V = 3072, C_GA = 4608, C_XR = 5120, C_GR = 7168, C_GM = 9216;
constexpr int C_TA = 1536;
constexpr int C_M = C_XR;
constexpr float ALPHA = 1.4142135623730951f, LN_EPS = 1e-5f;
constexpr float LOG2E = 1.4426950408889634f, LN2 = 0.6931471805599453f;

constexpr size_t MiB = 1u << 20;
constexpr size_t WS_BIAS = 1 * MiB, WS_WIN = 2 * MiB, WS_WA = 106 * MiB, WS_WR = 110 * MiB, WS_WO = 126 * MiB, WS_LW = 142 * MiB,
                 WS_XB = 146 * MiB, WS_Z = 306 * MiB, WS_LSE = 930 * MiB, WS_AGG = 932 * MiB, WS_CARRY = 944 * MiB, WS_END = 950 * MiB;
constexpr int LDS_BYTES = 147456;

__device__ const unsigned char T5B[3][129] = {
{11,11,11,11,11,11,11,11,11,11,11,11,11,11,11,10,10,10,10,10,10,10,10,10,10,10,10,10,10,10,10,10,10,10,10,10,10,10,9,9,9,9,9,9,9,9,9,9,9,9,8,8,8,8,8,8,8,7,6,5,4,3,2,1,0,17,18,19,20,21,22,23,24,24,24,24,24,24,24,25,25,25,25,25,25,25,25,25,25,25,25,26,26,26,26,26,26,26,26,26,26,26,26,26,26,26,26,26,26,26,26,26,26,26,27,27,27,27,27,27,27,27,27,27,27,27,27,27,27},
{13,13,13,13,13,13,13,13,13,13,13,13,13,13,13,13,13,13,13,13,13,13,13,12,12,12,12,12,12,12,12,12,12,12,12,12,12,12,12,12,12,12,11,11,11,11,11,11,11,11,11,11,10,10,10,10,10,10,9,9,9,8,8,4,0,20,24,24,25,25,25,26,26,26,26,26,26,27,27,27,27,27,27,27,27,27,27,28,28,28,28,28,28,28,28,28,28,28,28,28,28,28,28,28,28,28,29,29,29,29,29,29,29,29,29,29,29,29,29,29,29,29,29,29,29,29,29,29,29},
{15,15,15,15,15,15,15,15,15,15,15,15,15,15,15,15,15,15,15,15,15,15,15,15,15,15,15,15,15,15,14,14,14,14,14,14,14,14,14,14,14,14,14,14,14,13,13,13,13,13,13,13,13,13,12,12,12,12,12,11,11,10,10,9,0,25,26,26,27,27,28,28,28,28,28,29,29,29,29,29,29,29,29,29,30,30,30,30,30,30,30,30,30,30,30,30,30,30,30,31,31,31,31,31,31,31,31,31,31,31,31,31,31,31,31,31,31,31,31,31,31,31,31,31,31,31,31,31,31}};

__device__ __forceinline__ unsigned cvt_pk_bf16(float lo, float hi) { unsigned r; asm volatile("v_cvt_pk_bf16_f32 %0, %1, %2" : "=v"(r) : "v"(lo), "v"(hi)); return r; }
__device__ __forceinline__ float bf_lo(unsigned u) { return __uint_as_float(u << 16); }
__device__ __forceinline__ float bf_hi(unsigned u) { return __uint_as_float(u & 0xffff0000u); }
__device__ __forceinline__ float bf1(bf16_t u) { return __uint_as_float(((unsigned)u) << 16); }
__device__ __forceinline__ float sigm(float x) { return __builtin_amdgcn_rcpf(1.0f + __expf(-x)); }
__device__ __forceinline__ float silu(float x) { return x * sigm(x); }

namespace pg8 {
constexpr int BM = 256, BK = 64, HALF = 128, HTB = HALF * BK * 2, STAGE_BYTES = 8 * HTB, NXCD = 8, WGM = 8;
__host__ __device__ __forceinline__ int lds_byte(int r, int c) { const int st = (r >> 4) * 2 + (c >> 5), rr = r & 15, cc = c & 31, ob = rr * 64 + cc * 2; return st * 1024 + (ob ^ (((ob >> 9) & 1) << 5)); }
__host__ __device__ __forceinline__ void stage_rc(int b, int& R, int& C) { const int st = b / 1024, sb = b % 1024, swz = sb ^ (((sb >> 9) & 1) << 5); R = (st >> 1) * 16 + swz / 64; C = (st & 1) * 32 + (swz % 64) / 2; }
__host__ __device__ __forceinline__ int perm32(int rho) { const int n = rho >> 4, i = rho & 15; return 8 * (i >> 2) + 4 * n + (i & 3); }

struct Unit { int pm, pn; };
struct Gemm { const bf16_t* A; const bf16_t* Bt; int M, N, K, lda; };

struct StaticOrder {
    int nM, nN, nwg, G, c;
    __host__ __device__ void init(int M, int N, int G_, int c_) { nM = M / BM; nN = N / BM; nwg = nM * nN; G = G_; c = c_; }
    __host__ __device__ bool next(int i, Unit& u) const {
        const long L = (long)i * G + c; if (L >= nwg) return false;
        int wgid = (int)L; { const int q = nwg / NXCD, r = nwg % NXCD, xcd = wgid % NXCD, off = wgid / NXCD; wgid = (xcd < r ? xcd * (q + 1) : r * (q + 1) + (xcd - r) * q) + off; }
        const int nig = WGM * nN, gid = wgid / nig, fm = gid * WGM, gsz = (nM - fm) < WGM ? (nM - fm) : WGM;
        u.pm = fm + ((wgid % nig) % gsz); u.pn = (wgid % nig) / gsz; return true;
    }
};

struct EpiIn {
    bf16_t* O; int ldc; const float* bias;
    __device__ __forceinline__ void operator()(const f32x4 (&acc)[2][2][4][2], const Unit& u, int wr, int wc, int fr, int fq) const {
        const int row0 = u.pm * BM + wr * 64 + fr; const int col0 = u.pn * BM + wc * 32 + 8 * fq;
        f32x4 bv[2][2];
#pragma unroll
        for (int bj = 0; bj < 2; ++bj)
#pragma unroll
            for (int n = 0; n < 2; ++n) bv[bj][n] = *(const f32x4*)(bias + col0 + bj * HALF + 4 * n);
#pragma unroll
        for (int ai = 0; ai < 2; ++ai)
#pragma unroll
            for (int m = 0; m < 4; ++m) { bf16_t* rowp = O + (size_t)(row0 + ai * HALF + m * 16) * ldc + col0;
#pragma unroll
                for (int bj = 0; bj < 2; ++bj) { const f32x4 v0 = acc[ai][bj][m][0] + bv[bj][0], v1 = acc[ai][bj][m][1] + bv[bj][1];
                    u32x4 w; w.x = cvt_pk_bf16(v0[0], v0[1]); w.y = cvt_pk_bf16(v0[2], v0[3]); w.z = cvt_pk_bf16(v1[0], v1[1]); w.w = cvt_pk_bf16(v1[2], v1[3]);
                    *(u32x4*)(rowp + bj * HALF) = w; } }
    }
};
struct EpiGateA {
    bf16_t* Z;
    __device__ __forceinline__ void operator()(const f32x4 (&acc)[2][2][4][2], const Unit& u, int wr, int wc, int fr, int fq) const {
        const int row0 = u.pm * BM + wr * 64 + fr; const int col0 = u.pn * BM + wc * 32 + 8 * fq;
#pragma unroll
        for (int ai = 0; ai < 2; ++ai)
#pragma unroll
            for (int m = 0; m < 4; ++m) { bf16_t* zr = Z + (size_t)(row0 + ai * HALF + m * 16) * NIN + col0;
#pragma unroll
                for (int bj = 0; bj < 2; ++bj) { const f32x4 v0 = acc[ai][bj][m][0], v1 = acc[ai][bj][m][1];
                    const u32x4 g = *(const u32x4*)(zr + C_GM + bj * HALF);
                    u32x4 w; w.x = cvt_pk_bf16(v0[0] * sigm(bf_lo(g.x)), v0[1] * sigm(bf_hi(g.x))); w.y = cvt_pk_bf16(v0[2] * sigm(bf_lo(g.y)), v0[3] * sigm(bf_hi(g.y)));
                    w.z = cvt_pk_bf16(v1[0] * sigm(bf_lo(g.z)), v1[1] * sigm(bf_hi(g.z))); w.w = cvt_pk_bf16(v1[2] * sigm(bf_lo(g.w)), v1[3] * sigm(bf_hi(g.w)));
                    *(u32x4*)(zr + C_TA + bj * HALF) = w; } }
    }
};
struct EpiGateR {
    bf16_t* Z;
    __device__ __forceinline__ void operator()(const f32x4 (&acc)[2][2][4][2], const Unit& u, int wr, int wc, int fr, int fq) const {
        const int row0 = u.pm * BM + wr * 64 + fr; const int col0 = u.pn * BM + wc * 32 + 8 * fq;
#pragma unroll
        for (int ai = 0; ai < 2; ++ai)
#pragma unroll
            for (int m = 0; m < 4; ++m) { bf16_t* zr = Z + (size_t)(row0 + ai * HALF + m * 16) * NIN + col0;
#pragma unroll
                for (int bj = 0; bj < 2; ++bj) { const f32x4 v0 = acc[ai][bj][m][0], v1 = acc[ai][bj][m][1];
                    const u32x4 g = *(const u32x4*)(zr + C_GM + DM + bj * HALF);
                    const u32x4 t = *(const u32x4*)(zr + C_TA + bj * HALF);
                    u32x4 w; w.x = cvt_pk_bf16(bf_lo(t.x) + v0[0] * sigm(bf_lo(g.x)), bf_hi(t.x) + v0[1] * sigm(bf_hi(g.x)));
                    w.y = cvt_pk_bf16(bf_lo(t.y) + v0[2] * sigm(bf_lo(g.y)), bf_hi(t.y) + v0[3] * sigm(bf_hi(g.y)));
                    w.z = cvt_pk_bf16(bf_lo(t.z) + v1[0] * sigm(bf_lo(g.z)), bf_hi(t.z) + v1[1] * sigm(bf_hi(g.z)));
                    w.w = cvt_pk_bf16(bf_lo(t.w) + v1[2] * sigm(bf_lo(g.w)), bf_hi(t.w) + v1[3] * sigm(bf_hi(g.w)));
                    *(u32x4*)(zr + C_M + bj * HALF) = w; } }
    }
};
struct EpiRes {
    const float* xinA; const float* xinB; int split; float* out;
    __device__ __forceinline__ void operator()(const f32x4 (&acc)[2][2][4][2], const Unit& u, int wr, int wc, int fr, int fq) const {
        const int row0 = u.pm * BM + wr * 64 + fr; const int col0 = u.pn * BM + wc * 32 + 8 * fq;
        const float* xb_ = (u.pm * BM < split) ? xinA : xinB - (size_t)split * DM;
#pragma unroll
        for (int ai = 0; ai < 2; ++ai)
#pragma unroll
            for (int m = 0; m < 4; ++m) { const size_t off = (size_t)(row0 + ai * HALF + m * 16) * DM + col0;
#pragma unroll
                for (int bj = 0; bj < 2; ++bj) {
                    const f32x4 x0 = *(const f32x4*)(xb_ + off + bj * HALF), x1 = *(const f32x4*)(xb_ + off + bj * HALF + 4);
                    const f32x4 o0 = x0 * ALPHA + acc[ai][bj][m][0], o1 = x1 * ALPHA + acc[ai][bj][m][1];
                    *(f32x4*)(out + off + bj * HALF) = o0; *(f32x4*)(out + off + bj * HALF + 4) = o1; } }
    }
};

template <class Epi>
__device__ __forceinline__ void gemm_phase(LAS unsigned char* lds, const Gemm g, const StaticOrder& S, const Epi& E) {
    int tid = threadIdx.x; asm volatile("" : "+v"(tid));
    const int wid = __builtin_amdgcn_readfirstlane(tid >> 6), lane = tid & 63, wr = wid >> 2, wc = wid & 3, fr = lane & 15, fq = lane >> 4;
    const int K = g.K, nt = K / BK, lda = g.lda;
    unsigned voffA[2], voffB[2];
#pragma unroll
    for (int i = 0; i < 2; ++i) { int R, C; stage_rc(tid * 16 + i * 8192, R, C); const int Rb = (R & ~31) + perm32(R & 31);
        voffA[i] = (unsigned)(R * lda + C) * 2u; voffB[i] = (unsigned)(Rb * K + C) * 2u; }
    const size_t kstep = (size_t)(BK * 2);
    const size_t hstepA = (size_t)HALF * lda * 2, hstepB = (size_t)HALF * K * 2;
    const size_t tstepA = 2 * hstepA, tstepB = 2 * hstepB;
    const unsigned ldsw = (unsigned)wid * 1024u;
    const int aoff = lds_byte(wr * 64 + fr, fq * 8), boff = lds_byte(wc * 32 + fr, fq * 8);
#define PG8_SA(b, h) (((b) * 2 + (h)) * HTB)
#define PG8_SB(b, h) ((4 + (b) * 2 + (h)) * HTB)
#define PG8_STAGE(bufoff, gbase, voff) do { _Pragma("unroll") for (int _i = 0; _i < 2; ++_i) \
        __builtin_amdgcn_global_load_lds((const unsigned*)((const char*)(gbase) + (voff)[_i]), (LAS unsigned*)(lds + (bufoff) + ldsw + _i * 8192), 16, 0, 0); } while (0)
#define PG8_LDA(dst, b, h) do { _Pragma("unroll") for (int m = 0; m < 4; ++m) _Pragma("unroll") for (int k = 0; k < 2; ++k) dst[m][k] = *(const LAS bf16x8*)(lds + PG8_SA(b, h) + aoff + m * 2048 + k * 1024); } while (0)
#define PG8_LDB(dst, b, h) do { _Pragma("unroll") for (int n = 0; n < 2; ++n) _Pragma("unroll") for (int k = 0; k < 2; ++k) dst[n][k] = *(const LAS bf16x8*)(lds + PG8_SB(b, h) + boff + n * 2048 + k * 1024); } while (0)
#define PG8_MMA(ai, bj, At, Bt) do { __builtin_amdgcn_s_setprio(1); _Pragma("unroll") for (int m = 0; m < 4; ++m) _Pragma("unroll") for (int n = 0; n < 2; ++n) _Pragma("unroll") for (int k = 0; k < 2; ++k) \
        acc[ai][bj][m][n] = __builtin_amdgcn_mfma_f32_16x16x32_bf16(Bt[n][k], At[m][k], acc[ai][bj][m][n], 0, 0, 0); __builtin_amdgcn_s_setprio(0); } while (0)
#define PG8_WAIT_V(n) asm volatile("s_waitcnt vmcnt(" #n ")" ::: "memory")
#define PG8_WAIT_L(n) asm volatile("s_waitcnt lgkmcnt(" #n ")" ::: "memory")
#define PG8_BAR __builtin_amdgcn_s_barrier()
#define PG8_SCHED __builtin_amdgcn_sched_barrier(0)
    Unit cur, nxt; int ui = 0;
    if (!S.next(0, cur)) return;
    f32x4 acc[2][2][4][2];
#pragma unroll
    for (int a = 0; a < 2; ++a)
#pragma unroll
        for (int b = 0; b < 2; ++b)
#pragma unroll
            for (int m = 0; m < 4; ++m)
#pragma unroll
                for (int n = 0; n < 2; ++n) acc[a][b][m][n] = (f32x4){0.f, 0.f, 0.f, 0.f};
    bf16x8 At[4][2], B0[2][2], B1[2][2];
    const char* cA = (const char*)g.A + (size_t)cur.pm * tstepA; const char* cB = (const char*)g.Bt + (size_t)cur.pn * tstepB;
    PG8_STAGE(PG8_SB(0, 0), cB, voffB); PG8_STAGE(PG8_SB(0, 1), cB + hstepB, voffB); PG8_STAGE(PG8_SA(0, 0), cA, voffA); PG8_STAGE(PG8_SA(0, 1), cA + hstepA, voffA);
    if (wr == 1) PG8_BAR;
    PG8_WAIT_V(2); PG8_BAR;
    PG8_STAGE(PG8_SB(1, 0), cB + kstep, voffB); PG8_STAGE(PG8_SA(1, 0), cA + kstep, voffA); PG8_STAGE(PG8_SB(1, 1), cB + hstepB + kstep, voffB);
    PG8_WAIT_V(6); PG8_BAR;
    for (;;) {
        const bool has_next = S.next(ui + 1, nxt);
        const char* nA = has_next ? (const char*)g.A + (size_t)nxt.pm * tstepA : cA; const char* nB = has_next ? (const char*)g.Bt + (size_t)nxt.pn * tstepB : cB;
        for (int t = 0; t < nt; t += 2) {
            const bool last = (t == nt - 2);
            const char* a1 = cA + (size_t)(t + 1) * kstep;
            const char* a2 = last ? nA : cA + (size_t)(t + 2) * kstep; const char* b2 = last ? nB : cB + (size_t)(t + 2) * kstep;
            const char* a3 = a2 + kstep; const char* b3 = b2 + kstep;
            PG8_LDB(B0, 0, 0); PG8_LDB(B1, 0, 1); PG8_SCHED; PG8_LDA(At, 0, 0); PG8_STAGE(PG8_SA(1, 1), a1 + hstepA, voffA);
            PG8_WAIT_V(8); PG8_WAIT_L(0); PG8_BAR; PG8_MMA(0, 0, At, B0); PG8_MMA(0, 1, At, B1); PG8_BAR; PG8_SCHED;
            PG8_LDA(At, 0, 1); PG8_STAGE(PG8_SB(0, 0), b2, voffB); PG8_STAGE(PG8_SB(0, 1), b2 + hstepB, voffB); PG8_STAGE(PG8_SA(0, 0), a2, voffA);
            PG8_WAIT_V(8); PG8_WAIT_L(0); PG8_BAR; PG8_MMA(1, 0, At, B0); PG8_MMA(1, 1, At, B1); PG8_BAR; PG8_SCHED;
            PG8_LDB(B0, 1, 0); PG8_LDB(B1, 1, 1); PG8_SCHED; PG8_LDA(At, 1, 0); PG8_STAGE(PG8_SA(0, 1), a2 + hstepA, voffA);
            PG8_WAIT_V(8); PG8_WAIT_L(0); PG8_BAR; PG8_MMA(0, 0, At, B0); PG8_MMA(0, 1, At, B1); PG8_BAR; PG8_SCHED;
            PG8_LDA(At, 1, 1); PG8_STAGE(PG8_SB(1, 0), b3, voffB); PG8_STAGE(PG8_SB(1, 1), b3 + hstepB, voffB); PG8_STAGE(PG8_SA(1, 0), a3, voffA);
            PG8_WAIT_V(8); PG8_WAIT_L(0); PG8_BAR; PG8_MMA(1, 0, At, B0); PG8_MMA(1, 1, At, B1); PG8_BAR; PG8_SCHED;
        }
        if (wr == 0) PG8_BAR;
        E(acc, cur, wr, wc, fr, fq);
        if (!has_next) break;
#pragma unroll
        for (int a = 0; a < 2; ++a)
#pragma unroll
            for (int b = 0; b < 2; ++b)
#pragma unroll
                for (int m = 0; m < 4; ++m)
#pragma unroll
                    for (int n = 0; n < 2; ++n) acc[a][b][m][n] = (f32x4){0.f, 0.f, 0.f, 0.f};
        cur = nxt; cA = nA; cB = nB; ++ui;
        if (wr == 1) PG8_BAR;
    }
    PG8_WAIT_V(0);
    PG8_BAR;
#undef PG8_SA
#undef PG8_SB
#undef PG8_STAGE
#undef PG8_LDA
#undef PG8_LDB
#undef PG8_MMA
#undef PG8_WAIT_V
#undef PG8_WAIT_L
#undef PG8_BAR
#undef PG8_SCHED
}
}

__device__ __forceinline__ unsigned f2bf(float f) { unsigned u = __builtin_bit_cast(unsigned, f); return (u + 0x7fffu + ((u >> 16) & 1u)) >> 16; }
__device__ __forceinline__ unsigned pk2(float lo, float hi) { return f2bf(lo) | (f2bf(hi) << 16); }
__device__ __forceinline__ void p0_transpose_item(const float* W, int K, int N, bf16_t* WT, LAS float* scr, int item, int lane) {
    const int nblk = N / 32, kb = item / nblk, nb = item % nblk, k0 = 64 * kb, n0 = 32 * nb;
#pragma unroll 8
    for (int i = 0; i < 32; ++i) { const int kk = 2 * i + (lane >> 5); scr[kk * 33 + (lane & 31)] = W[(size_t)(k0 + kk) * N + n0 + (lane & 31)]; }
    asm volatile("s_waitcnt lgkmcnt(0)" ::: "memory");
    const int c = lane & 7;
#pragma unroll
    for (int j = 0; j < 4; ++j) { const int n = (lane >> 3) + 8 * j; const LAS float* s = scr + (8 * c) * 33 + n;
        u32x4 o; o.x = pk2(s[0 * 33], s[1 * 33]); o.y = pk2(s[2 * 33], s[3 * 33]); o.z = pk2(s[4 * 33], s[5 * 33]); o.w = pk2(s[6 * 33], s[7 * 33]);
        *(u32x4*)(WT + (size_t)(n0 + n) * K + k0 + 8 * c) = o; }
    asm volatile("s_waitcnt lgkmcnt(0)" ::: "memory");
}

constexpr int KVS = 272;
constexpr int LDS_K = 0, LDS_V = 256 * KVS, LDS_SB = 2 * 256 * KVS;
__device__ __forceinline__ void attn_phase(LAS unsigned char* lds, bf16_t* Z, int S, float* lse, const float* biasTab, int bid, int G) {
    int tid = threadIdx.x; asm volatile("" : "+v"(tid));
    const int lane = tid & 63, w = __builtin_amdgcn_readfirstlane(tid >> 6), l15 = lane & 15, quad = lane >> 4;
    const int nunits = 12 * (S >> 7);
    for (int u = bid; u < nunits; u += G) {
        const int hd = u % 12, rest = u / 12, g = hd >> 2, dsh = 2 * g;
        const int Lsub = S >> dsh, cpr = Lsub >> 7, r = rest / cpr, jc = rest - r * cpr, j0 = jc << 7;
        {
            const int c = tid & 15, rbase = tid >> 4;
            u32x4 kk[8], vv[8];
#pragma unroll
            for (int it = 0; it < 8; ++it) { const int i = rbase + 32 * it, j = j0 - 64 + i; const bool ok = (j >= 0) && (j < Lsub);
                const int jcl = ok ? j : 0; const bf16_t* p = Z + ((size_t)((jcl << dsh) + r)) * NIN + hd * 128 + c * 8;
                u32x4 a = *(const u32x4*)(p + C_K), b = *(const u32x4*)(p + C_V);
                if (!ok) { a = (u32x4){0u, 0u, 0u, 0u}; b = a; }
                kk[it] = a; vv[it] = b; }
#pragma unroll
            for (int it = 0; it < 8; ++it) { const int i = rbase + 32 * it;
                *(LAS u32x4*)(lds + LDS_K + i * KVS + c * 16) = kk[it]; *(LAS u32x4*)(lds + LDS_V + i * KVS + c * 16) = vv[it]; }
            if (tid < 129) ((LAS float*)(lds + LDS_SB))[tid] = biasTab[hd * 129 + tid];
        }
        const int jq = j0 + 16 * w + l15; const size_t tokq = ((size_t)jq << dsh) + r;
        bf16_t* qrow = Z + tokq * NIN + hd * 128;
        bf16x8 qf[4];
#pragma unroll
        for (int ks = 0; ks < 4; ++ks) qf[ks] = *(const bf16x8*)(qrow + ks * 32 + quad * 8);
        __syncthreads();
        f32x4 sacc[9];
        const LAS unsigned char* kbase = lds + LDS_K + (16 * w + l15) * KVS + quad * 16;
#pragma unroll
        for (int kt = 0; kt < 9; ++kt) { f32x4 a4 = (f32x4){0.f, 0.f, 0.f, 0.f};
#pragma unroll
            for (int ks = 0; ks < 4; ++ks) { const bf16x8 a = *(const LAS bf16x8*)(kbase + kt * 16 * KVS + ks * 64); a4 = __builtin_amdgcn_mfma_f32_16x16x32_bf16(a, qf[ks], a4, 0, 0, 0); }
            sacc[kt] = a4; }
        const float sc = 0.08838834764831845f * LOG2E;
        const LAS float* sb = (const LAS float*)(lds + LDS_SB);
        float mx = -1e30f;
#pragma unroll
        for (int kt = 0; kt < 9; ++kt)
#pragma unroll
            for (int i = 0; i < 4; ++i) { const int c = 16 * kt + 4 * quad + i, o64 = c - l15, jk = j0 + 16 * w - 64 + c;
                const bool valid = (o64 >= 0) && (o64 <= 128) && (jk >= 0) && (jk < Lsub);
                const int oc = o64 < 0 ? 0 : (o64 > 128 ? 128 : o64);
                const float s = valid ? (sacc[kt][i] * sc + sb[oc]) : -1e30f;
                sacc[kt][i] = s; mx = fmaxf(mx, s); }
        mx = fmaxf(mx, __shfl_xor(mx, 16)); mx = fmaxf(mx, __shfl_xor(mx, 32));
        float den = 0.f;
#pragma unroll
        for (int kt = 0; kt < 9; ++kt)
#pragma unroll
            for (int i = 0; i < 4; ++i) { const float p = __builtin_amdgcn_exp2f(sacc[kt][i] - mx); sacc[kt][i] = p; den += p; }
        den += __shfl_xor(den, 16); den += __shfl_xor(den, 32);
        bf16x8 pb[5];
#pragma unroll
        for (int s = 0; s < 5; ++s) { const f32x4 lo = sacc[2 * s]; const f32x4 hi = (2 * s + 1 < 9) ? sacc[(2 * s + 1 < 9) ? 2 * s + 1 : 8] : (f32x4){0.f, 0.f, 0.f, 0.f};
            u32x4 pk; pk.x = cvt_pk_bf16(lo[0], lo[1]); pk.y = cvt_pk_bf16(lo[2], lo[3]); pk.z = cvt_pk_bf16(hi[0], hi[1]); pk.w = cvt_pk_bf16(hi[2], hi[3]);
            pb[s] = __builtin_bit_cast(bf16x8, pk); }
        f32x4 oacc[8];
        const LAS unsigned char* vbase = lds + LDS_V + (16 * w + 4 * quad + (l15 >> 2)) * KVS + (l15 & 3) * 8;
#pragma unroll
        for (int dt = 0; dt < 8; ++dt) { f32x4 o4 = (f32x4){0.f, 0.f, 0.f, 0.f};
#pragma unroll
            for (int s = 0; s < 5; ++s) {
                const s16x4 lo = __builtin_bit_cast(s16x4, __builtin_amdgcn_ds_read_tr16_b64_v4i16((LAS s16x4*)(vbase + (s * 32) * KVS + dt * 32)));
                s16x4 hi = (s16x4){0, 0, 0, 0};
                if (s < 4) hi = __builtin_bit_cast(s16x4, __builtin_amdgcn_ds_read_tr16_b64_v4i16((LAS s16x4*)(vbase + (s * 32 + 16) * KVS + dt * 32)));
                const bf16x8 a = (bf16x8){lo[0], lo[1], lo[2], lo[3], hi[0], hi[1], hi[2], hi[3]};
                o4 = __builtin_amdgcn_mfma_f32_16x16x32_bf16(a, pb[s], o4, 0, 0, 0); }
            oacc[dt] = o4; }
        const float inv = 1.0f / den;
#pragma unroll
        for (int dt = 0; dt < 8; ++dt) { u32x2 o2; o2.x = cvt_pk_bf16(oacc[dt][0] * inv, oacc[dt][1] * inv); o2.y = cvt_pk_bf16(oacc[dt][2] * inv, oacc[dt][3] * inv);
            *(u32x2*)(qrow + 16 * dt + 4 * quad) = o2; }
        if (quad == 0) lse[tokq * 12 + hd] = (mx + __log2f(den)) * LN2;
        __syncthreads();
    }
}

__device__ __forceinline__ void combine_phase(bf16_t* Z, int S, const float* lse, int bid, int G) {
    int tid = threadIdx.x; asm volatile("" : "+v"(tid));
    const int lane = tid & 63, gw = bid * 8 + (tid >> 6), NGW = G * 8;
    const int h = lane >> 4, dc = lane & 15;
    for (int row = gw; row < S; row += NGW) {
        bf16_t* zr = Z + (size_t)row * NIN;
        const float l0 = lse[(size_t)row * 12 + h], l1 = lse[(size_t)row * 12 + 4 + h], l2 = lse[(size_t)row * 12 + 8 + h];
        const float m = fmaxf(l0, fmaxf(l1, l2));
        float e0 = __expf(l0 - m), e1 = __expf(l1 - m), e2 = __expf(l2 - m); const float inv = 1.0f / (e0 + e1 + e2); e0 *= inv; e1 *= inv; e2 *= inv;
        const u32x4 a = *(const u32x4*)(zr + (0 + h) * 128 + dc * 8), b = *(const u32x4*)(zr + (4 + h) * 128 + dc * 8), c = *(const u32x4*)(zr + (8 + h) * 128 + dc * 8);
        const u32x4 ga = *(const u32x4*)(zr + C_GA + h * 128 + dc * 8);
        u32x4 o;
#define CMB(f) o.f = cvt_pk_bf16((e0 * bf_lo(a.f) + e1 * bf_lo(b.f) + e2 * bf_lo(c.f)) * silu(bf_lo(ga.f)), (e0 * bf_hi(a.f) + e1 * bf_hi(b.f) + e2 * bf_hi(c.f)) * silu(bf_hi(ga.f)))
        CMB(x); CMB(y); CMB(z); CMB(w);
#undef CMB
        *(u32x4*)(zr + C_GA + h * 128 + dc * 8) = o;
    }
}

constexpr int XCF_STRIDE = 132, LDS_XCF = 0, LDS_XCB = 64 * XCF_STRIDE * 4, LDS_CW = LDS_XCB + 64 * KVS;
__device__ __forceinline__ float sigm2(float x) { return __builtin_amdgcn_rcpf(1.0f + __builtin_amdgcn_exp2f(x * -LOG2E)); }
template <int PASS>
__device__ __forceinline__ void lru_phase(LAS unsigned char* lds, bf16_t* Z, int S, const float* convw, const float* convb, const bf16_t* LWt, const float* lrub, const float* lam,
                                          f32x2* __restrict__ AGG, const float* __restrict__ CARRY, int bid, int G) {
    int tid = threadIdx.x; asm volatile("" : "+v"(tid));
    const int lane = tid & 63, w = __builtin_amdgcn_readfirstlane(tid >> 6), l15 = lane & 15, quad = lane >> 4;
    LAS float* xcf = (LAS float*)(lds + LDS_XCF);
    LAS float* cw = (LAS float*)(lds + LDS_CW);
    const int nb16 = G >> 4, n = bid & 15, cfirst = bid >> 4, NC = S >> 6;
    if (cfirst >= nb16) return;
    const int chl = 16 * w + l15, ch = n * 128 + chl;
    for (int i = tid; i < 5 * 128; i += 512) { const int j = i >> 7, ci = i & 127; cw[i] = (j < 4) ? convw[j * DM + n * 128 + ci] : convb[n * 128 + ci]; }
    bf16x8 bw[2][2][4]; float br[2], bi[2], k8[2];
#pragma unroll
    for (int dir = 0; dir < 2; ++dir) {
#pragma unroll
        for (int gt = 0; gt < 2; ++gt)
#pragma unroll
            for (int ks = 0; ks < 4; ++ks) bw[dir][gt][ks] = *(const bf16x8*)(LWt + ((size_t)(((dir * 2 + gt) * 16 + n) * 128 + chl)) * 128 + ks * 32 + quad * 8);
        br[dir] = lrub[((dir * 2 + 0) * 16 + n) * 128 + chl]; bi[dir] = lrub[((dir * 2 + 1) * 16 + n) * 128 + chl];
        k8[dir] = -8.0f * LOG2E * log1pf(__expf(-lam[dir * DM + ch]));
    }
    __syncthreads();
    for (int c = cfirst; c < NC; c += nb16) {
        const int t0 = c * 64;
#pragma unroll
        for (int k = 0; k < 2; ++k) { const int item = tid + 512 * k, tt = item >> 4, cc = item & 15;
            f32x4 x0 = *(const LAS f32x4*)(cw + 4 * 128 + cc * 8), x1 = *(const LAS f32x4*)(cw + 4 * 128 + cc * 8 + 4);
#pragma unroll
            for (int j = 0; j < 4; ++j) { const int row = t0 + tt + j - 2;
                if (row >= 0 && row < S) { const u32x4 x = *(const u32x4*)(Z + (size_t)row * NIN + C_XR + n * 128 + cc * 8);
                    const f32x4 w0 = *(const LAS f32x4*)(cw + j * 128 + cc * 8), w1 = *(const LAS f32x4*)(cw + j * 128 + cc * 8 + 4);
                    x0[0] += bf_lo(x.x) * w0[0]; x0[1] += bf_hi(x.x) * w0[1]; x0[2] += bf_lo(x.y) * w0[2]; x0[3] += bf_hi(x.y) * w0[3];
                    x1[0] += bf_lo(x.z) * w1[0]; x1[1] += bf_hi(x.z) * w1[1]; x1[2] += bf_lo(x.w) * w1[2]; x1[3] += bf_hi(x.w) * w1[3]; } }
            *(LAS f32x4*)(xcf + tt * XCF_STRIDE + cc * 8) = x0; *(LAS f32x4*)(xcf + tt * XCF_STRIDE + cc * 8 + 4) = x1;
            u32x4 pk; pk.x = cvt_pk_bf16(x0[0], x0[1]); pk.y = cvt_pk_bf16(x0[2], x0[3]); pk.z = cvt_pk_bf16(x1[0], x1[1]); pk.w = cvt_pk_bf16(x1[2], x1[3]);
            *(LAS u32x4*)(lds + LDS_XCB + (16 * ((tt >> 2) & 3) + 4 * (tt >> 4) + (tt & 3)) * KVS + cc * 16) = pk; }
        __syncthreads();
        float hsum[4][4];
#pragma unroll
        for (int dir = 0; dir < 2; ++dir) {
            f32x4 ga[2][4];
#pragma unroll
            for (int mt = 0; mt < 4; ++mt) { ga[0][mt] = (f32x4){0.f, 0.f, 0.f, 0.f}; ga[1][mt] = (f32x4){0.f, 0.f, 0.f, 0.f};
#pragma unroll
                for (int ks = 0; ks < 4; ++ks) { const bf16x8 a = *(const LAS bf16x8*)(lds + LDS_XCB + (16 * mt + l15) * KVS + ks * 64 + quad * 16);
                    ga[0][mt] = __builtin_amdgcn_mfma_f32_16x16x32_bf16(a, bw[dir][0][ks], ga[0][mt], 0, 0, 0);
                    ga[1][mt] = __builtin_amdgcn_mfma_f32_16x16x32_bf16(a, bw[dir][1][ks], ga[1][mt], 0, 0, 0); } }
            float av[4][4], bv[4][4];
#pragma unroll
            for (int mt = 0; mt < 4; ++mt)
#pragma unroll
                for (int i = 0; i < 4; ++i) { const float rg = sigm2(ga[0][mt][i] + br[dir]), ig = sigm2(ga[1][mt][i] + bi[dir]);
                    const float xcv = xcf[(16 * quad + 4 * mt + i) * XCF_STRIDE + chl];
                    const float av_ = __builtin_amdgcn_exp2f(k8[dir] * rg);
                    av[mt][i] = av_; bv[mt][i] = __builtin_amdgcn_sqrtf(fmaxf(1.0f - av_ * av_, 0.f)) * (ig * xcv); }
            float H = 0.f, Ptot = 1.f;
            if (PASS == 1) H = CARRY[(size_t)(c * 2 + dir) * DM + ch];
            if (dir == 0) {
                float As = 1.f, Bs = 0.f;
#pragma unroll
                for (int mt = 0; mt < 4; ++mt)
#pragma unroll
                    for (int i = 0; i < 4; ++i) { Bs = av[mt][i] * Bs + bv[mt][i]; As *= av[mt][i]; }
                float Ap = __shfl_up(As, 16), Bp = __shfl_up(Bs, 16); if (quad >= 1) { Bs = As * Bp + Bs; As = Ap * As; }
                Ap = __shfl_up(As, 32); Bp = __shfl_up(Bs, 32); if (quad >= 2) { Bs = As * Bp + Bs; As = Ap * As; }
                float Ae = __shfl_up(As, 16), Be = __shfl_up(Bs, 16); if (quad == 0) { Ae = 1.f; Be = 0.f; }
                const float At = __shfl(As, 48 + l15), Bt = __shfl(Bs, 48 + l15);
                float h = Ae * H + Be; H = At * H + Bt; Ptot = At;
#pragma unroll
                for (int mt = 0; mt < 4; ++mt)
#pragma unroll
                    for (int i = 0; i < 4; ++i) { h = av[mt][i] * h + bv[mt][i]; hsum[mt][i] = h; }
            } else {
                float As = 1.f, Bs = 0.f;
#pragma unroll
                for (int mt = 3; mt >= 0; --mt)
#pragma unroll
                    for (int i = 3; i >= 0; --i) { Bs = av[mt][i] * Bs + bv[mt][i]; As *= av[mt][i]; }
                float Ap = __shfl_down(As, 16), Bp = __shfl_down(Bs, 16); if (quad <= 2) { Bs = As * Bp + Bs; As = Ap * As; }
                Ap = __shfl_down(As, 32); Bp = __shfl_down(Bs, 32); if (quad <= 1) { Bs = As * Bp + Bs; As = Ap * As; }
                float Ae = __shfl_down(As, 16), Be = __shfl_down(Bs, 16); if (quad == 3) { Ae = 1.f; Be = 0.f; }
                const float At = __shfl(As, l15), Bt = __shfl(Bs, l15);
                float h = Ae * H + Be; H = At * H + Bt; Ptot = At;
#pragma unroll
                for (int mt = 3; mt >= 0; --mt)
#pragma unroll
                    for (int i = 3; i >= 0; --i) { h = av[mt][i] * h + bv[mt][i]; hsum[mt][i] += h; }
            }
            if (PASS == 0) { if (quad == 0) AGG[(size_t)(c * 2 + dir) * DM + ch] = (f32x2){Ptot, H}; }
        }
        if (PASS == 1) {
            __syncthreads();
#pragma unroll
            for (int mt = 0; mt < 4; ++mt)
#pragma unroll
                for (int i = 0; i < 4; ++i) xcf[(16 * quad + 4 * mt + i) * XCF_STRIDE + chl] = hsum[mt][i];
            __syncthreads();
#pragma unroll
            for (int k = 0; k < 2; ++k) { const int item = tid + 512 * k, tt = item >> 4, cc = item & 15;
                const f32x4 h0 = *(const LAS f32x4*)(xcf + tt * XCF_STRIDE + cc * 8), h1 = *(const LAS f32x4*)(xcf + tt * XCF_STRIDE + cc * 8 + 4);
                bf16_t* p = Z + (size_t)(t0 + tt) * NIN + C_GR + n * 128 + cc * 8;
                const u32x4 g = *(const u32x4*)p;
                u32x4 o; o.x = cvt_pk_bf16(h0[0] * silu(bf_lo(g.x)), h0[1] * silu(bf_hi(g.x))); o.y = cvt_pk_bf16(h0[2] * silu(bf_lo(g.y)), h0[3] * silu(bf_hi(g.y)));
                o.z = cvt_pk_bf16(h1[0] * silu(bf_lo(g.z)), h1[1] * silu(bf_hi(g.z))); o.w = cvt_pk_bf16(h1[2] * silu(bf_lo(g.w)), h1[3] * silu(bf_hi(g.w)));
                *(u32x4*)p = o; }
        }
        __syncthreads();
    }
}

__device__ __forceinline__ void carry_phase(LAS unsigned char* lds, const f32x2* __restrict__ AGG, float* __restrict__ CARRY, int S, int bid, int G) {
    int tid = threadIdx.x; asm volatile("" : "+v"(tid));
    const int NC = S >> 6, SEG = NC >> 4, seg = tid >> 5, cl = tid & 31;
    LAS f32x2* sagg = (LAS f32x2*)lds;
    for (int cb = bid; cb < (2 * DM) / 32; cb += G) {
        const int chain = cb * 32 + cl, dir = chain >> 11, ch = chain & (DM - 1);
        float Ae[16], Be[16]; float A = 1.f, B = 0.f;
#pragma unroll
        for (int k = 0; k < 16; ++k) { Ae[k] = A; Be[k] = B;
            if (k < SEG) { const int p = seg * SEG + k, c = dir ? (NC - 1 - p) : p; const f32x2 ab = AGG[(size_t)(c * 2 + dir) * DM + ch]; B = ab.x * B + ab.y; A = ab.x * A; } }
        sagg[seg * 32 + cl] = (f32x2){A, B};
        __syncthreads();
        float h = 0.f;
        for (int s2 = 0; s2 < seg; ++s2) { const f32x2 ab = sagg[s2 * 32 + cl]; h = ab.x * h + ab.y; }
#pragma unroll
        for (int k = 0; k < 16; ++k) if (k < SEG) { const int p = seg * SEG + k, c = dir ? (NC - 1 - p) : p; CARRY[(size_t)(c * 2 + dir) * DM + ch] = Ae[k] * h + Be[k]; }
        __syncthreads();
    }
}

__device__ __forceinline__ void ln_phase(float* io, bf16_t* xb, int S, const float* lng, const float* lnb, int bid, int G) {
    int tid = threadIdx.x; asm volatile("" : "+v"(tid));
    const int lane = tid & 63, gw = bid * 8 + (tid >> 6), NGW = G * 8;
    f32x4 gv[8], bv[8];
#pragma unroll
    for (int j = 0; j < 8; ++j) { gv[j] = ((const f32x4*)lng)[lane + 64 * j]; bv[j] = ((const f32x4*)lnb)[lane + 64 * j]; }
    for (int row = gw; row < S; row += NGW) {
        f32x4* p = (f32x4*)(io + (size_t)row * DM);
        f32x4 v[8]; float s = 0.f;
#pragma unroll
        for (int j = 0; j < 8; ++j) { v[j] = p[lane + 64 * j]; s += (v[j][0] + v[j][1]) + (v[j][2] + v[j][3]); }
#pragma unroll
        for (int o = 1; o < 64; o <<= 1) s += __shfl_xor(s, o);
        const float mean = s * (1.0f / DM); float q = 0.f;
#pragma unroll
        for (int j = 0; j < 8; ++j) { v[j] = v[j] - mean; q += (v[j][0] * v[j][0] + v[j][1] * v[j][1]) + (v[j][2] * v[j][2] + v[j][3] * v[j][3]); }
#pragma unroll
        for (int o = 1; o < 64; o <<= 1) q += __shfl_xor(q, o);
        const float rstd = 1.0f / sqrtf(q * (1.0f / DM) + LN_EPS);
#pragma unroll
        for (int j = 0; j < 8; ++j) { const f32x4 y = v[j] * rstd * gv[j] + bv[j]; p[lane + 64 * j] = y;
            if (xb) { u32x2 o2; o2.x = cvt_pk_bf16(y[0], y[1]); o2.y = cvt_pk_bf16(y[2], y[3]); ((u32x2*)(xb + (size_t)row * DM))[lane + 64 * j] = o2; } }
    }
}


#define XB_TMO      128
#define XB_XCNT(j)  (256  + 64 * (j))
#define XB_XSUB(j)  (1280 + 64 * (j))
#define XB_XGEN(j)  (2304 + 64 * (j))
#define XB_TOP      3328
#define XB_TOPGEN   3392
#define XCD_BAR_WORDS 3456
#define XB_SPIN_CAP (1u << 22)
__device__ __forceinline__ unsigned xb_ld(unsigned* p)              { return __hip_atomic_load(p, __ATOMIC_RELAXED, __HIP_MEMORY_SCOPE_AGENT); }
__device__ __forceinline__ unsigned xb_add(unsigned* p, unsigned v) { return __hip_atomic_fetch_add(p, v, __ATOMIC_RELAXED, __HIP_MEMORY_SCOPE_AGENT); }
__device__ __forceinline__ unsigned xb_xcc_id() { return (unsigned)__builtin_amdgcn_s_getreg((3 << 11) | 20) & 0xFu; }
#define XB_SPIN(cond, bar) do { unsigned _sp = 0; while (cond) { __builtin_amdgcn_s_sleep(1); \
    if ((++_sp & 255u) == 0u) { if (xb_ld(&(bar)[XB_TMO])) break; if (_sp > XB_SPIN_CAP) { atomicAdd(&(bar)[XB_TMO], 1u); break; } } } } while (0)
struct XcdBarrier { unsigned* bar; unsigned x; volatile LAS unsigned* st; };
__device__ __forceinline__ XcdBarrier xcd_barrier_post(unsigned* bar, volatile LAS unsigned* st) {
    XcdBarrier b; b.bar = bar; b.x = xb_xcc_id(); b.st = st;
    if (threadIdx.x == 0) (void)xb_add(&bar[XB_XCNT(b.x)], 1u);
    return b;
}
__device__ __forceinline__ void xcd_barrier_complete(unsigned* bar, unsigned x, unsigned& nloc, unsigned& nx) {
    const unsigned G = gridDim.x * gridDim.y * gridDim.z;
    unsigned sum, cnt, mine, sp = 0u;
    for (;;) {
        sum = 0u; cnt = 0u; mine = 0u;
#pragma unroll
        for (unsigned j = 0; j < 16; ++j) { const unsigned c = xb_ld(&bar[XB_XCNT(j)]); sum += c; cnt += (c > 0u) ? 1u : 0u; mine = (j == x) ? c : mine; }
        if (sum == G) break;
        __builtin_amdgcn_s_sleep(1);
        if ((++sp & 255u) == 0u) { if (xb_ld(&bar[XB_TMO])) break; if (sp > XB_SPIN_CAP) { atomicAdd(&bar[XB_TMO], 1u); break; } }
    }
    nloc = mine > 0u ? mine : 1u; nx = cnt > 0u ? cnt : 1u;
}
__device__ __forceinline__ void xcd_barrier(const XcdBarrier& b) {
    asm volatile("s_waitcnt vmcnt(0)" ::: "memory");
    __syncthreads();
    if (threadIdx.x == 0) {
        unsigned* bar = b.bar;
        __builtin_amdgcn_s_waitcnt(0);
        unsigned nloc = b.st[0], nx = b.st[1];
        if (nloc == 0u) { xcd_barrier_complete(bar, b.x, nloc, nx); b.st[0] = nloc; b.st[1] = nx; }
        const unsigned old = xb_add(&bar[XB_XSUB(b.x)], 1u);
        const unsigned gen = old / nloc;
        if (old + 1u == (gen + 1u) * nloc) {
            __builtin_amdgcn_fence(__ATOMIC_RELEASE, "agent");
            asm volatile("s_waitcnt vmcnt(0)" ::: "memory");
            const unsigned og = xb_add(&bar[XB_TOP], 1u);
            const unsigned tg = og / nx;
            if (og + 1u == (tg + 1u) * nx) xb_add(&bar[XB_TOPGEN], 1u);
            else XB_SPIN(xb_ld(&bar[XB_TOPGEN]) == tg, bar);
            __builtin_amdgcn_fence(__ATOMIC_ACQUIRE, "agent");
            xb_add(&bar[XB_XGEN(b.x)], 1u);
            asm volatile("s_waitcnt vmcnt(0)" ::: "memory");
        } else {
            XB_SPIN(xb_ld(&bar[XB_XGEN(b.x)]) == gen, bar);
            __builtin_amdgcn_fence(__ATOMIC_ACQUIRE, "agent");
            asm volatile("s_waitcnt vmcnt(0)" ::: "memory");
        }
    }
    __syncthreads();
}

struct Args { const float* in[15]; float* out; unsigned char* ws; };

__global__ void __launch_bounds__(512, 2) fwd_kernel(Args a) {
    extern __shared__ __attribute__((aligned(16))) unsigned char lds_raw[];
    LAS unsigned char* lds = (LAS unsigned char*)lds_raw;
    cg::grid_group grid = cg::this_grid();
    const int tid = threadIdx.x, lane = tid & 63, wave = __builtin_amdgcn_readfirstlane(tid >> 6);
    const int G = gridDim.x, bid = blockIdx.x;
    const int gw = bid * 8 + wave, NGW = G * 8;
    unsigned char* ws = a.ws;
    float* biasTab = (float*)(ws + WS_BIAS);
    bf16_t* WIN = (bf16_t*)(ws + WS_WIN); bf16_t* WA = (bf16_t*)(ws + WS_WA); bf16_t* WR = (bf16_t*)(ws + WS_WR); bf16_t* WO = (bf16_t*)(ws + WS_WO); bf16_t* LW = (bf16_t*)(ws + WS_LW);
    bf16_t* XB = (bf16_t*)(ws + WS_XB); bf16_t* Z = (bf16_t*)(ws + WS_Z);
    float* LSE = (float*)(ws + WS_LSE); f32x2* AGG = (f32x2*)(ws + WS_AGG); float* CARRY = (float*)(ws + WS_CARRY);

    unsigned* barw = (unsigned*)ws;
    volatile LAS unsigned* bst = (volatile LAS unsigned*)(lds + LDS_BYTES - 64);
    if (bid == 0) { for (int i = tid; i < XCD_BAR_WORDS; i += 512) __hip_atomic_store(barw + i, 0u, __ATOMIC_RELAXED, __HIP_MEMORY_SCOPE_AGENT); }
    if (tid == 0) { bst[0] = 0u; bst[1] = 0u; }
    {
        LAS float* scr = (LAS float*)(lds + wave * 16384);
        constexpr int I_IN = (DM / 64) * (NIN / 32), I_A = (512 / 64) * (DM / 32), I_R = (DM / 64) * (DM / 32), I_L = 2 * 4;
        constexpr int NITEMS = 2 * I_IN + 2 * I_A + 4 * I_R + 128 * I_L;
        for (int it = gw; it < NITEMS; it += NGW) {
            int r = it;
            if (r < 2 * I_IN) { const int l = r / I_IN; p0_transpose_item(a.in[2] + (size_t)l * DM * NIN, DM, NIN, WIN + (size_t)l * NIN * DM, scr, r % I_IN, lane); continue; } r -= 2 * I_IN;
            if (r < 2 * I_A) { const int l = r / I_A; p0_transpose_item(a.in[9] + (size_t)l * 512 * DM, 512, DM, WA + (size_t)l * DM * 512, scr, r % I_A, lane); continue; } r -= 2 * I_A;
            if (r < 2 * I_R) { const int l = r / I_R; p0_transpose_item(a.in[10] + (size_t)l * DM * DM, DM, DM, WR + (size_t)l * DM * DM, scr, r % I_R, lane); continue; } r -= 2 * I_R;
            if (r < 2 * I_R) { const int l = r / I_R; p0_transpose_item(a.in[11] + (size_t)l * DM * DM, DM, DM, WO + (size_t)l * DM * DM, scr, r % I_R, lane); continue; } r -= 2 * I_R;
            { const int mtx = r / I_L; p0_transpose_item(a.in[6] + (size_t)mtx * 16384, 128, 128, LW + (size_t)mtx * 16384, scr, r % I_L, lane); }
        }
        const int gt = bid * 512 + tid, GT = G * 512;
        for (int i = gt; i < NTOK * (DM / 8); i += GT) {
            const size_t e = (size_t)i * 8; const float* src = (e < (size_t)8192 * DM) ? (a.in[0] + e) : (a.in[1] + (e - (size_t)8192 * DM));
            const f32x4 x0 = *(const f32x4*)src, x1 = *(const f32x4*)(src + 4);
            u32x4 o; o.x = cvt_pk_bf16(x0[0], x0[1]); o.y = cvt_pk_bf16(x0[2], x0[3]); o.z = cvt_pk_bf16(x1[0], x1[1]); o.w = cvt_pk_bf16(x1[2], x1[3]);
            *(u32x4*)(XB + e) = o;
        }
        for (int i = gt; i < 12 * 129; i += GT) { const int hd = i / 129, k = i % 129; biasTab[i] = a.in[14][(int)T5B[hd >> 2][k] * 12 + hd] * LOG2E; }
    }
    __threadfence();
    grid.sync();
    const XcdBarrier xbar = xcd_barrier_post(barw, bst);

#pragma nounroll
    for (int step = 0; step < 4; ++step) {
        const int l = step >> 1, bb = step & 1;
        const int SR = bb ? 16384 : 24576, rowoff = bb ? 24576 : 0, nseq = bb ? 1 : 2;
        float* outb = a.out + (size_t)rowoff * DM;
        const float* convw = a.in[4] + (size_t)l * 4 * DM; const float* convb = a.in[5] + (size_t)l * DM; const bf16_t* LWl = LW + (size_t)l * 64 * 16384;
        const float* lrub = a.in[7] + (size_t)l * 64 * 128; const float* lam = a.in[8] + (size_t)l * 2 * DM;
        { pg8::Gemm g{XB + (size_t)rowoff * DM, WIN + (size_t)l * NIN * DM, SR, NIN, DM, DM}; pg8::StaticOrder so; so.init(SR, NIN, G, bid);
          pg8::EpiIn E{Z, NIN, a.in[3] + (size_t)l * NIN}; pg8::gemm_phase<pg8::EpiIn>(lds, g, so, E); }
        xcd_barrier(xbar);
#pragma nounroll
        for (int sq = 0; sq < nseq; ++sq) { const int so_ = (sq == 0) ? 0 : 8192, S = (bb == 0 && sq == 0) ? 8192 : 16384;
            attn_phase(lds, Z + (size_t)so_ * NIN, S, LSE + (size_t)so_ * 12, biasTab, bid, G); }
#pragma nounroll
        for (int sq = 0; sq < nseq; ++sq) { const int so_ = (sq == 0) ? 0 : 8192, S = (bb == 0 && sq == 0) ? 8192 : 16384;
            lru_phase<0>(lds, Z + (size_t)so_ * NIN, S, convw, convb, LWl, lrub, lam, AGG + (size_t)(so_ >> 6) * 2 * DM, CARRY + (size_t)(so_ >> 6) * 2 * DM, bid, G); }
        xcd_barrier(xbar);
#pragma nounroll
        for (int sq = 0; sq < nseq; ++sq) { const int so_ = (sq == 0) ? 0 : 8192, S = (bb == 0 && sq == 0) ? 8192 : 16384;
            carry_phase(lds, AGG + (size_t)(so_ >> 6) * 2 * DM, CARRY + (size_t)(so_ >> 6) * 2 * DM, S, (bid + 128 * sq) % G, G); }
        xcd_barrier(xbar);
#pragma nounroll
        for (int sq = 0; sq < nseq; ++sq) { const int so_ = (sq == 0) ? 0 : 8192, S = (bb == 0 && sq == 0) ? 8192 : 16384;
            lru_phase<1>(lds, Z + (size_t)so_ * NIN, S, convw, convb, LWl, lrub, lam, AGG + (size_t)(so_ >> 6) * 2 * DM, CARRY + (size_t)(so_ >> 6) * 2 * DM, bid, G); }
        combine_phase(Z, SR, LSE, bid, G);
        xcd_barrier(xbar);
        { pg8::Gemm g{Z + C_GA, WA + (size_t)l * DM * 512, SR, DM, 512, NIN}; pg8::StaticOrder so; so.init(SR, DM, G, bid);
          pg8::EpiGateA E{Z}; pg8::gemm_phase<pg8::EpiGateA>(lds, g, so, E); }
        { pg8::Gemm g{Z + C_GR, WR + (size_t)l * DM * DM, SR, DM, DM, NIN}; pg8::StaticOrder so; so.init(SR, DM, G, bid);
          pg8::EpiGateR E{Z}; pg8::gemm_phase<pg8::EpiGateR>(lds, g, so, E); }
        xcd_barrier(xbar);
        { const float* xA = (l == 0) ? (bb ? a.in[1] + (size_t)16384 * DM : a.in[0]) : outb;
          const float* xB = (l == 0) ? a.in[1] : outb + (size_t)8192 * DM;
          const int split = bb ? SR : 8192;
          pg8::Gemm g{Z + C_M, WO + (size_t)l * DM * DM, SR, DM, DM, NIN}; pg8::StaticOrder so; so.init(SR, DM, G, bid);
          pg8::EpiRes E{xA, xB, split, outb}; pg8::gemm_phase<pg8::EpiRes>(lds, g, so, E); }
        xcd_barrier(xbar);
        ln_phase(outb, (l == 0) ? (XB + (size_t)rowoff * DM) : (bf16_t*)nullptr, SR, a.in[12] + (size_t)l * DM, a.in[13] + (size_t)l * DM, bid, G);
    }
}

extern "C" void kernel_launch(void* const* d_in, const int* in_sizes, int n_in, void* d_out, int out_size, void* d_ws, size_t ws_size, hipStream_t stream) {
    static int grid = 0;
    if (grid == 0) {
        if (n_in != 15 || out_size != NTOK * DM || ws_size < WS_END) { fprintf(stderr, "kernel_launch: unexpected shapes (n_in %d out %d ws %zu)\n", n_in, out_size, ws_size); grid = -1; return; }
        int dev = 0, cus = 0, per_cu = 0;
        (void)hipGetDevice(&dev);
        (void)hipDeviceGetAttribute(&cus, hipDeviceAttributeMultiprocessorCount, dev);
        (void)hipFuncSetAttribute((const void*)fwd_kernel, hipFuncAttributeMaxDynamicSharedMemorySize, LDS_BYTES);
        (void)hipOccupancyMaxActiveBlocksPerMultiprocessor(&per_cu, (const void*)fwd_kernel, 512, LDS_BYTES);
        if (per_cu < 1) per_cu = 1;
        grid = cus * per_cu;
    }
    if (grid < 0) return;
    Args a{};
    for (int i = 0; i < 15; ++i) a.in[i] = (const float*)d_in[i];
    a.out = (float*)d_out; a.ws = (unsigned char*)d_ws;
    void* args[] = {&a};
    hipError_t e = hipLaunchCooperativeKernel((const void*)fwd_kernel, dim3(grid), dim3(512), args, LDS_BYTES, stream);
    if (e != hipSuccess) fprintf(stderr, "cooperative launch failed: %s (grid %d)\n", hipGetErrorString(e), grid);
}
```

```cpp
#include <hip/hip_runtime.h>
#include <hip/hip_cooperative_groups.h>
#include <cstdio>
#include <cstdint>
namespace cg = cooperative_groups;

#define LAS __attribute__((address_space(3)))
typedef unsigned short bf16_t;
typedef short bf16x8 __attribute__((ext_vector_type(8)));
typedef short s16x4 __attribute__((ext_vector_type(4)));
typedef float f32x4 __attribute__((ext_vector_type(4)));
typedef float f32x2 __attribute__((ext_vector_type(2)));
typedef unsigned u32x4 __attribute__((ext_vector_type(4)));
typedef unsigned u32x2 __attribute__((ext_vector_type(2)));

constexpr int DM = 2048, NIN = 13312, NTOK = 40960;
constexpr int C_Q = 0, C_K = 1536, C_V = 3072, C_GA = 4608, C_XR = 5120, C_GR = 7168, C_GM = 9216;
constexpr int C_TA = 1536;
constexpr int C_M = C_XR;
constexpr float ALPHA = 1.4142135623730951f, LN_EPS = 1e-5f;
constexpr float LOG2E = 1.4426950408889634f, LN2 = 0.6931471805599453f;

constexpr size_t MiB = 1u << 20;
constexpr size_t WS_BIAS = 1 * MiB, WS_WIN = 2 * MiB, WS_WA = 106 * MiB, WS_WR = 110 * MiB, WS_WO = 126 * MiB, WS_LW = 142 * MiB,
                 WS_XB = 146 * MiB, WS_Z = 306 * MiB, WS_LSE = 930 * MiB, WS_AGG = 932 * MiB, WS_CARRY = 944 * MiB, WS_END = 950 * MiB;
constexpr int LDS_BYTES = 147456;

__device__ const unsigned char T5B[3][129] = {
{11,11,11,11,11,11,11,11,11,11,11,11,11,11,11,10,10,10,10,10,10,10,10,10,10,10,10,10,10,10,10,10,10,10,10,10,10,10,9,9,9,9,9,9,9,9,9,9,9,9,8,8,8,8,8,8,8,7,6,5,4,3,2,1,0,17,18,19,20,21,22,23,24,24,24,24,24,24,24,25,25,25,25,25,25,25,25,25,25,25,25,26,26,26,26,26,26,26,26,26,26,26,26,26,26,26,26,26,26,26,26,26,26,26,27,27,27,27,27,27,27,27,27,27,27,27,27,27,27},
{13,13,13,13,13,13,13,13,13,13,13,13,13,13,13,13,13,13,13,13,13,13,13,12,12,12,12,12,12,12,12,12,12,12,12,12,12,12,12,12,12,12,11,11,11,11,11,11,11,11,11,11,10,10,10,10,10,10,9,9,9,8,8,4,0,20,24,24,25,25,25,26,26,26,26,26,26,27,27,27,27,27,27,27,27,27,27,28,28,28,28,28,28,28,28,28,28,28,28,28,28,28,28,28,28,28,29,29,29,29,29,29,29,29,29,29,29,29,29,29,29,29,29,29,29,29,29,29,29},
{15,15,15,15,15,15,15,15,15,15,15,15,15,15,15,15,15,15,15,15,15,15,15,15,15,15,15,15,15,15,14,14,14,14,14,14,14,14,14,14,14,14,14,14,14,13,13,13,13,13,13,13,13,13,12,12,12,12,12,11,11,10,10,9,0,25,26,26,27,27,28,28,28,28,28,29,29,29,29,29,29,29,29,29,30,30,30,30,30,30,30,30,30,30,30,30,30,30,30,31,31,31,31,31,31,31,31,31,31,31,31,31,31,31,31,31,31,31,31,31,31,31,31,31,31,31,31,31,31}};

__device__ __forceinline__ unsigned cvt_pk_bf16(float lo, float hi) { unsigned r; asm volatile("v_cvt_pk_bf16_f32 %0, %1, %2" : "=v"(r) : "v"(lo), "v"(hi)); return r; }
__device__ __forceinline__ float bf_lo(unsigned u) { return __uint_as_float(u << 16); }
__device__ __forceinline__ float bf_hi(unsigned u) { return __uint_as_float(u & 0xffff0000u); }
__device__ __forceinline__ float bf1(bf16_t u) { return __uint_as_float(((unsigned)u) << 16); }
__device__ __forceinline__ float sigm(float x) { return __builtin_amdgcn_rcpf(1.0f + __expf(-x)); }
__device__ __forceinline__ float silu(float x) { return x * sigm(x); }
#define LBAR() do { asm volatile("s_waitcnt lgkmcnt(0)" ::: "memory"); __builtin_amdgcn_s_barrier(); asm volatile("" ::: "memory"); } while (0)

namespace pg8 {
constexpr int BM = 256, BK = 64, HALF = 128, HTB = HALF * BK * 2, STAGE_BYTES = 8 * HTB, NXCD = 8, WGM = 8;
__host__ __device__ __forceinline__ int lds_byte(int r, int c) { const int st = (r >> 4) * 2 + (c >> 5), rr = r & 15, cc = c & 31, ob = rr * 64 + cc * 2; return st * 1024 + (ob ^ (((ob >> 9) & 1) << 5)); }
__host__ __device__ __forceinline__ void stage_rc(int b, int& R, int& C) { const int st = b / 1024, sb = b % 1024, swz = sb ^ (((sb >> 9) & 1) << 5); R = (st >> 1) * 16 + swz / 64; C = (st & 1) * 32 + (swz % 64) / 2; }
__host__ __device__ __forceinline__ int perm32(int rho) { const int n = rho >> 4, i = rho & 15; return 8 * (i >> 2) + 4 * n + (i & 3); }

struct Unit { int pm, pn; };
struct Gemm { const bf16_t* A; const bf16_t* Bt; int M, N, K, lda; };

struct StaticOrder {
    int nM, nN, nwg, G, c;
    __host__ __device__ void init(int M, int N, int G_, int c_) { nM = M / BM; nN = N / BM; nwg = nM * nN; G = G_; c = c_; }
    __host__ __device__ bool next(int i, Unit& u) const {
        const long L = (long)i * G + c; if (L >= nwg) return false;
        int wgid = (int)L; { const int q = nwg / NXCD, r = nwg % NXCD, xcd = wgid % NXCD, off = wgid / NXCD; wgid = (xcd < r ? xcd * (q + 1) : r * (q + 1) + (xcd - r) * q) + off; }
        const int nig = WGM * nN, gid = wgid / nig, fm = gid * WGM, gsz = (nM - fm) < WGM ? (nM - fm) : WGM;
        u.pm = fm + ((wgid % nig) % gsz); u.pn = (wgid % nig) / gsz; return true;
    }
};

struct EpiIn {
    bf16_t* O; int ldc; const float* bias;
    __device__ __forceinline__ void operator()(const f32x4 (&acc)[2][2][4][2], const Unit& u, int wr, int wc, int fr, int fq) const {
        const int row0 = u.pm * BM + wr * 64 + fr; const int col0 = u.pn * BM + wc * 32 + 8 * fq;
        f32x4 bv[2][2];
#pragma unroll
        for (int bj = 0; bj < 2; ++bj)
#pragma unroll
            for (int n = 0; n < 2; ++n) bv[bj][n] = *(const f32x4*)(bias + col0 + bj * HALF + 4 * n);
#pragma unroll
        for (int ai = 0; ai < 2; ++ai)
#pragma unroll
            for (int m = 0; m < 4; ++m) { bf16_t* rowp = O + (size_t)(row0 + ai * HALF + m * 16) * ldc + col0;
#pragma unroll
                for (int bj = 0; bj < 2; ++bj) { const f32x4 v0 = acc[ai][bj][m][0] + bv[bj][0], v1 = acc[ai][bj][m][1] + bv[bj][1];
                    u32x4 w; w.x = cvt_pk_bf16(v0[0], v0[1]); w.y = cvt_pk_bf16(v0[2], v0[3]); w.z = cvt_pk_bf16(v1[0], v1[1]); w.w = cvt_pk_bf16(v1[2], v1[3]);
                    *(u32x4*)(rowp + bj * HALF) = w; } }
    }
};
struct EpiGateA {
    bf16_t* Z;
    __device__ __forceinline__ void operator()(const f32x4 (&acc)[2][2][4][2], const Unit& u, int wr, int wc, int fr, int fq) const {
        const int row0 = u.pm * BM + wr * 64 + fr; const int col0 = u.pn * BM + wc * 32 + 8 * fq;
#pragma unroll
        for (int ai = 0; ai < 2; ++ai)
#pragma unroll
            for (int m = 0; m < 4; ++m) { bf16_t* zr = Z + (size_t)(row0 + ai * HALF + m * 16) * NIN + col0;
#pragma unroll
                for (int bj = 0; bj < 2; ++bj) { const f32x4 v0 = acc[ai][bj][m][0], v1 = acc[ai][bj][m][1];
                    const u32x4 g = *(const u32x4*)(zr + C_GM + bj * HALF);
                    u32x4 w; w.x = cvt_pk_bf16(v0[0] * sigm(bf_lo(g.x)), v0[1] * sigm(bf_hi(g.x))); w.y = cvt_pk_bf16(v0[2] * sigm(bf_lo(g.y)), v0[3] * sigm(bf_hi(g.y)));
                    w.z = cvt_pk_bf16(v1[0] * sigm(bf_lo(g.z)), v1[1] * sigm(bf_hi(g.z))); w.w = cvt_pk_bf16(v1[2] * sigm(bf_lo(g.w)), v1[3] * sigm(bf_hi(g.w)));
                    *(u32x4*)(zr + C_TA + bj * HALF) = w; } }
    }
};
struct EpiGateR {
    bf16_t* Z;
    __device__ __forceinline__ void operator()(const f32x4 (&acc)[2][2][4][2], const Unit& u, int wr, int wc, int fr, int fq) const {
        const int row0 = u.pm * BM + wr * 64 + fr; const int col0 = u.pn * BM + wc * 32 + 8 * fq;
#pragma unroll
        for (int ai = 0; ai < 2; ++ai)
#pragma unroll
            for (int m = 0; m < 4; ++m) { bf16_t* zr = Z + (size_t)(row0 + ai * HALF + m * 16) * NIN + col0;
#pragma unroll
                for (int bj = 0; bj < 2; ++bj) { const f32x4 v0 = acc[ai][bj][m][0], v1 = acc[ai][bj][m][1];
                    const u32x4 g = *(const u32x4*)(zr + C_GM + DM + bj * HALF);
                    const u32x4 t = *(const u32x4*)(zr + C_TA + bj * HALF);
                    u32x4 w; w.x = cvt_pk_bf16(bf_lo(t.x) + v0[0] * sigm(bf_lo(g.x)), bf_hi(t.x) + v0[1] * sigm(bf_hi(g.x)));
                    w.y = cvt_pk_bf16(bf_lo(t.y) + v0[2] * sigm(bf_lo(g.y)), bf_hi(t.y) + v0[3] * sigm(bf_hi(g.y)));
                    w.z = cvt_pk_bf16(bf_lo(t.z) + v1[0] * sigm(bf_lo(g.z)), bf_hi(t.z) + v1[1] * sigm(bf_hi(g.z)));
                    w.w = cvt_pk_bf16(bf_lo(t.w) + v1[2] * sigm(bf_lo(g.w)), bf_hi(t.w) + v1[3] * sigm(bf_hi(g.w)));
                    *(u32x4*)(zr + C_M + bj * HALF) = w; } }
    }
};
struct EpiRes {
    const float* xinA; const float* xinB; int split; float* out;
    __device__ __forceinline__ void operator()(const f32x4 (&acc)[2][2][4][2], const Unit& u, int wr, int wc, int fr, int fq) const {
        const int row0 = u.pm * BM + wr * 64 + fr; const int col0 = u.pn * BM + wc * 32 + 8 * fq;
        const float* xb_ = (u.pm * BM < split) ? xinA : xinB - (size_t)split * DM;
#pragma unroll
        for (int ai = 0; ai < 2; ++ai)
#pragma unroll
            for (int m = 0; m < 4; ++m) { const size_t off = (size_t)(row0 + ai * HALF + m * 16) * DM + col0;
#pragma unroll
                for (int bj = 0; bj < 2; ++bj) {
                    const f32x4 x0 = *(const f32x4*)(xb_ + off + bj * HALF), x1 = *(const f32x4*)(xb_ + off + bj * HALF + 4);
                    const f32x4 o0 = x0 * ALPHA + acc[ai][bj][m][0], o1 = x1 * ALPHA + acc[ai][bj][m][1];
                    *(f32x4*)(out + off + bj * HALF) = o0; *(f32x4*)(out + off + bj * HALF + 4) = o1; } }
    }
};

template <class Epi>
__device__ __forceinline__ void gemm_phase(LAS unsigned char* lds, const Gemm g, const StaticOrder& S, const Epi& E) {
    int tid = threadIdx.x; asm volatile("" : "+v"(tid));
    const int wid = __builtin_amdgcn_readfirstlane(tid >> 6), lane = tid & 63, wr = wid >> 2, wc = wid & 3, fr = lane & 15, fq = lane >> 4;
    const int K = g.K, nt = K / BK, lda = g.lda;
    unsigned voffA[2], voffB[2];
#pragma unroll
    for (int i = 0; i < 2; ++i) { int R, C; stage_rc(tid * 16 + i * 8192, R, C); const int Rb = (R & ~31) + perm32(R & 31);
        voffA[i] = (unsigned)(R * lda + C) * 2u; voffB[i] = (unsigned)(Rb * K + C) * 2u; }
    const size_t kstep = (size_t)(BK * 2);
    const size_t hstepA = (size_t)HALF * lda * 2, hstepB = (size_t)HALF * K * 2;
    const size_t tstepA = 2 * hstepA, tstepB = 2 * hstepB;
    const unsigned ldsw = (unsigned)wid * 1024u;
    const int aoff = lds_byte(wr * 64 + fr, fq * 8), boff = lds_byte(wc * 32 + fr, fq * 8);
#define PG8_SA(b, h) (((b) * 2 + (h)) * HTB)
#define PG8_SB(b, h) ((4 + (b) * 2 + (h)) * HTB)
#define PG8_STAGE(bufoff, gbase, voff) do { _Pragma("unroll") for (int _i = 0; _i < 2; ++_i) \
        __builtin_amdgcn_global_load_lds((const unsigned*)((const char*)(gbase) + (voff)[_i]), (LAS unsigned*)(lds + (bufoff) + ldsw + _i * 8192), 16, 0, 0); } while (0)
#define PG8_LDA(dst, b, h) do { _Pragma("unroll") for (int m = 0; m < 4; ++m) _Pragma("unroll") for (int k = 0; k < 2; ++k) dst[m][k] = *(const LAS bf16x8*)(lds + PG8_SA(b, h) + aoff + m * 2048 + k * 1024); } while (0)
#define PG8_LDB(dst, b, h) do { _Pragma("unroll") for (int n = 0; n < 2; ++n) _Pragma("unroll") for (int k = 0; k < 2; ++k) dst[n][k] = *(const LAS bf16x8*)(lds + PG8_SB(b, h) + boff + n * 2048 + k * 1024); } while (0)
#define PG8_MMA(ai, bj, At, Bt) do { __builtin_amdgcn_s_setprio(1); _Pragma("unroll") for (int m = 0; m < 4; ++m) _Pragma("unroll") for (int n = 0; n < 2; ++n) _Pragma("unroll") for (int k = 0; k < 2; ++k) \
        acc[ai][bj][m][n] = __builtin_amdgcn_mfma_f32_16x16x32_bf16(Bt[n][k], At[m][k], acc[ai][bj][m][n], 0, 0, 0); __builtin_amdgcn_s_setprio(0); } while (0)
#define PG8_WAIT_V(n) asm volatile("s_waitcnt vmcnt(" #n ")" ::: "memory")
#define PG8_WAIT_L(n) asm volatile("s_waitcnt lgkmcnt(" #n ")" ::: "memory")
#define PG8_BAR __builtin_amdgcn_s_barrier()
#define PG8_SCHED __builtin_amdgcn_sched_barrier(0)
    Unit cur, nxt; int ui = 0;
    if (!S.next(0, cur)) return;
    f32x4 acc[2][2][4][2];
#pragma unroll
    for (int a = 0; a < 2; ++a)
#pragma unroll
        for (int b = 0; b < 2; ++b)
#pragma unroll
            for (int m = 0; m < 4; ++m)
#pragma unroll
                for (int n = 0; n < 2; ++n) acc[a][b][m][n] = (f32x4){0.f, 0.f, 0.f, 0.f};
    bf16x8 At[4][2], B0[2][2], B1[2][2];
    const char* cA = (const char*)g.A + (size_t)cur.pm * tstepA; const char* cB = (const char*)g.Bt + (size_t)cur.pn * tstepB;
    PG8_STAGE(PG8_SB(0, 0), cB, voffB); PG8_STAGE(PG8_SB(0, 1), cB + hstepB, voffB); PG8_STAGE(PG8_SA(0, 0), cA, voffA); PG8_STAGE(PG8_SA(0, 1), cA + hstepA, voffA);
    if (wr == 1) PG8_BAR;
    PG8_WAIT_V(2); PG8_BAR;
    PG8_STAGE(PG8_SB(1, 0), cB + kstep, voffB); PG8_STAGE(PG8_SA(1, 0), cA + kstep, voffA); PG8_STAGE(PG8_SB(1, 1), cB + hstepB + kstep, voffB);
    PG8_WAIT_V(6); PG8_BAR;
    for (;;) {
        const bool has_next = S.next(ui + 1, nxt);
        const char* nA = has_next ? (const char*)g.A + (size_t)nxt.pm * tstepA : cA; const char* nB = has_next ? (const char*)g.Bt + (size_t)nxt.pn * tstepB : cB;
        for (int t = 0; t < nt; t += 2) {
            const bool last = (t == nt - 2);
            const char* a1 = cA + (size_t)(t + 1) * kstep;
            const char* a2 = last ? nA : cA + (size_t)(t + 2) * kstep; const char* b2 = last ? nB : cB + (size_t)(t + 2) * kstep;
            const char* a3 = a2 + kstep; const char* b3 = b2 + kstep;
            PG8_LDB(B0, 0, 0); PG8_LDB(B1, 0, 1); PG8_SCHED; PG8_LDA(At, 0, 0); PG8_STAGE(PG8_SA(1, 1), a1 + hstepA, voffA);
            PG8_WAIT_V(8); PG8_WAIT_L(0); PG8_BAR; PG8_MMA(0, 0, At, B0); PG8_MMA(0, 1, At, B1); PG8_BAR; PG8_SCHED;
            PG8_LDA(At, 0, 1); PG8_STAGE(PG8_SB(0, 0), b2, voffB); PG8_STAGE(PG8_SB(0, 1), b2 + hstepB, voffB); PG8_STAGE(PG8_SA(0, 0), a2, voffA);
            PG8_WAIT_V(8); PG8_WAIT_L(0); PG8_BAR; PG8_MMA(1, 0, At, B0); PG8_MMA(1, 1, At, B1); PG8_BAR; PG8_SCHED;
            PG8_LDB(B0, 1, 0); PG8_LDB(B1, 1, 1); PG8_SCHED; PG8_LDA(At, 1, 0); PG8_STAGE(PG8_SA(0, 1), a2 + hstepA, voffA);
            PG8_WAIT_V(8); PG8_WAIT_L(0); PG8_BAR; PG8_MMA(0, 0, At, B0); PG8_MMA(0, 1, At, B1); PG8_BAR; PG8_SCHED;
            PG8_LDA(At, 1, 1); PG8_STAGE(PG8_SB(1, 0), b3, voffB); PG8_STAGE(PG8_SB(1, 1), b3 + hstepB, voffB); PG8_STAGE(PG8_SA(1, 0), a3, voffA);
            PG8_WAIT_V(8); PG8_WAIT_L(0); PG8_BAR; PG8_MMA(1, 0, At, B0); PG8_MMA(1, 1, At, B1); PG8_BAR; PG8_SCHED;
        }
        if (wr == 0) PG8_BAR;
        E(acc, cur, wr, wc, fr, fq);
        if (!has_next) break;
#pragma unroll
        for (int a = 0; a < 2; ++a)
#pragma unroll
            for (int b = 0; b < 2; ++b)
#pragma unroll
                for (int m = 0; m < 4; ++m)
#pragma unroll
                    for (int n = 0; n < 2; ++n) acc[a][b][m][n] = (f32x4){0.f, 0.f, 0.f, 0.f};
        cur = nxt; cA = nA; cB = nB; ++ui;
        if (wr == 1) PG8_BAR;
    }
    PG8_WAIT_V(0);
    PG8_BAR;
#undef PG8_SA
#undef PG8_SB
#undef PG8_STAGE
#undef PG8_LDA
#undef PG8_LDB
#undef PG8_MMA
#undef PG8_WAIT_V
#undef PG8_WAIT_L
#undef PG8_BAR
#undef PG8_SCHED
}
}

__device__ __forceinline__ unsigned f2bf(float f) { unsigned u = __builtin_bit_cast(unsigned, f); return (u + 0x7fffu + ((u >> 16) & 1u)) >> 16; }
__device__ __forceinline__ unsigned pk2(float lo, float hi) { return f2bf(lo) | (f2bf(hi) << 16); }
__device__ __forceinline__ void p0_transpose_item(const float* W, int K, int N, bf16_t* WT, LAS float* scr, int item, int lane) {
    const int nblk = N / 32, kb = item / nblk, nb = item % nblk, k0 = 64 * kb, n0 = 32 * nb;
#pragma unroll 8
    for (int i = 0; i < 32; ++i) { const int kk = 2 * i + (lane >> 5); scr[kk * 33 + (lane & 31)] = W[(size_t)(k0 + kk) * N + n0 + (lane & 31)]; }
    asm volatile("s_waitcnt lgkmcnt(0)" ::: "memory");
    const int c = lane & 7;
#pragma unroll
    for (int j = 0; j < 4; ++j) { const int n = (lane >> 3) + 8 * j; const LAS float* s = scr + (8 * c) * 33 + n;
        u32x4 o; o.x = pk2(s[0 * 33], s[1 * 33]); o.y = pk2(s[2 * 33], s[3 * 33]); o.z = pk2(s[4 * 33], s[5 * 33]); o.w = pk2(s[6 * 33], s[7 * 33]);
        *(u32x4*)(WT + (size_t)(n0 + n) * K + k0 + 8 * c) = o; }
    asm volatile("s_waitcnt lgkmcnt(0)" ::: "memory");
}

constexpr int KVS = 272;
constexpr int LDS_K = 0, LDS_V = 256 * KVS, LDS_SB = 2 * 256 * KVS;
__device__ __forceinline__ void attn_phase(LAS unsigned char* lds, bf16_t* Z, int S, float* lse, const float* biasTab, int bid, int G) {
    int tid = threadIdx.x; asm volatile("" : "+v"(tid));
    const int lane = tid & 63, w = __builtin_amdgcn_readfirstlane(tid >> 6), l15 = lane & 15, quad = lane >> 4;
    const int nunits = 12 * (S >> 7);
    for (int u = bid; u < nunits; u += G) {
        const int hd = u % 12, rest = u / 12, g = hd >> 2, dsh = 2 * g;
        const int Lsub = S >> dsh, cpr = Lsub >> 7, r = rest / cpr, jc = rest - r * cpr, j0 = jc << 7;
        {
            const int c = tid & 15, rbase = tid >> 4;
            u32x4 kk[8], vv[8];
#pragma unroll
            for (int it = 0; it < 8; ++it) { const int i = rbase + 32 * it, j = j0 - 64 + i; const bool ok = (j >= 0) && (j < Lsub);
                const int jcl = ok ? j : 0; const bf16_t* p = Z + ((size_t)((jcl << dsh) + r)) * NIN + hd * 128 + c * 8;
                u32x4 a = *(const u32x4*)(p + C_K), b = *(const u32x4*)(p + C_V);
                if (!ok) { a = (u32x4){0u, 0u, 0u, 0u}; b = a; }
                kk[it] = a; vv[it] = b; }
#pragma unroll
            for (int it = 0; it < 8; ++it) { const int i = rbase + 32 * it;
                *(LAS u32x4*)(lds + LDS_K + i * KVS + c * 16) = kk[it]; *(LAS u32x4*)(lds + LDS_V + i * KVS + c * 16) = vv[it]; }
            if (tid < 129) ((LAS float*)(lds + LDS_SB))[tid] = biasTab[hd * 129 + tid];
        }
        const int jq = j0 + 16 * w + l15; const size_t tokq = ((size_t)jq << dsh) + r;
        bf16_t* qrow = Z + tokq * NIN + hd * 128;
        bf16x8 qf[4];
#pragma unroll
        for (int ks = 0; ks < 4; ++ks) qf[ks] = *(const bf16x8*)(qrow + ks * 32 + quad * 8);
        __syncthreads();
        f32x4 sacc[9];
        const LAS unsigned char* kbase = lds + LDS_K + (16 * w + l15) * KVS + quad * 16;
#pragma unroll
        for (int kt = 0; kt < 9; ++kt) { f32x4 a4 = (f32x4){0.f, 0.f, 0.f, 0.f};
#pragma unroll
            for (int ks = 0; ks < 4; ++ks) { const bf16x8 a = *(const LAS bf16x8*)(kbase + kt * 16 * KVS + ks * 64); a4 = __builtin_amdgcn_mfma_f32_16x16x32_bf16(a, qf[ks], a4, 0, 0, 0); }
            sacc[kt] = a4; }
        const float sc = 0.08838834764831845f * LOG2E;
        const LAS float* sb = (const LAS float*)(lds + LDS_SB);
        float mx = -1e30f;
#pragma unroll
        for (int kt = 0; kt < 9; ++kt)
#pragma unroll
            for (int i = 0; i < 4; ++i) { const int c = 16 * kt + 4 * quad + i, o64 = c - l15, jk = j0 + 16 * w - 64 + c;
                const bool valid = (o64 >= 0) && (o64 <= 128) && (jk >= 0) && (jk < Lsub);
                const int oc = o64 < 0 ? 0 : (o64 > 128 ? 128 : o64);
                const float s = valid ? (sacc[kt][i] * sc + sb[oc]) : -1e30f;
                sacc[kt][i] = s; mx = fmaxf(mx, s); }
        mx = fmaxf(mx, __shfl_xor(mx, 16)); mx = fmaxf(mx, __shfl_xor(mx, 32));
        float den = 0.f;
#pragma unroll
        for (int kt = 0; kt < 9; ++kt)
#pragma unroll
            for (int i = 0; i < 4; ++i) { const float p = __builtin_amdgcn_exp2f(sacc[kt][i] - mx); sacc[kt][i] = p; den += p; }
        den += __shfl_xor(den, 16); den += __shfl_xor(den, 32);
        bf16x8 pb[5];
#pragma unroll
        for (int s = 0; s < 5; ++s) { const f32x4 lo = sacc[2 * s]; const f32x4 hi = (2 * s + 1 < 9) ? sacc[(2 * s + 1 < 9) ? 2 * s + 1 : 8] : (f32x4){0.f, 0.f, 0.f, 0.f};
            u32x4 pk; pk.x = cvt_pk_bf16(lo[0], lo[1]); pk.y = cvt_pk_bf16(lo[2], lo[3]); pk.z = cvt_pk_bf16(hi[0], hi[1]); pk.w = cvt_pk_bf16(hi[2], hi[3]);
            pb[s] = __builtin_bit_cast(bf16x8, pk); }
        f32x4 oacc[8];
        const LAS unsigned char* vbase = lds + LDS_V + (16 * w + 4 * quad + (l15 >> 2)) * KVS + (l15 & 3) * 8;
#pragma unroll
        for (int dt = 0; dt < 8; ++dt) { f32x4 o4 = (f32x4){0.f, 0.f, 0.f, 0.f};
#pragma unroll
            for (int s = 0; s < 5; ++s) {
                const s16x4 lo = __builtin_bit_cast(s16x4, __builtin_amdgcn_ds_read_tr16_b64_v4i16((LAS s16x4*)(vbase + (s * 32) * KVS + dt * 32)));
                s16x4 hi = (s16x4){0, 0, 0, 0};
                if (s < 4) hi = __builtin_bit_cast(s16x4, __builtin_amdgcn_ds_read_tr16_b64_v4i16((LAS s16x4*)(vbase + (s * 32 + 16) * KVS + dt * 32)));
                const bf16x8 a = (bf16x8){lo[0], lo[1], lo[2], lo[3], hi[0], hi[1], hi[2], hi[3]};
                o4 = __builtin_amdgcn_mfma_f32_16x16x32_bf16(a, pb[s], o4, 0, 0, 0); }
            oacc[dt] = o4; }
        const float inv = 1.0f / den;
#pragma unroll
        for (int dt = 0; dt < 8; ++dt) { u32x2 o2; o2.x = cvt_pk_bf16(oacc[dt][0] * inv, oacc[dt][1] * inv); o2.y = cvt_pk_bf16(oacc[dt][2] * inv, oacc[dt][3] * inv);
            *(u32x2*)(qrow + 16 * dt + 4 * quad) = o2; }
        if (quad == 0) lse[tokq * 12 + hd] = (mx + __log2f(den)) * LN2;
        __syncthreads();
    }
}

__device__ __forceinline__ void combine_phase(bf16_t* Z, int S, const float* lse, int bid, int G) {
    int tid = threadIdx.x; asm volatile("" : "+v"(tid));
    const int lane = tid & 63, gw = bid * 8 + (tid >> 6), NGW = G * 8;
    const int h = lane >> 4, dc = lane & 15;
    for (int row = gw; row < S; row += NGW) {
        bf16_t* zr = Z + (size_t)row * NIN;
        const float l0 = lse[(size_t)row * 12 + h], l1 = lse[(size_t)row * 12 + 4 + h], l2 = lse[(size_t)row * 12 + 8 + h];
        const float m = fmaxf(l0, fmaxf(l1, l2));
        float e0 = __expf(l0 - m), e1 = __expf(l1 - m), e2 = __expf(l2 - m); const float inv = 1.0f / (e0 + e1 + e2); e0 *= inv; e1 *= inv; e2 *= inv;
        const u32x4 a = *(const u32x4*)(zr + (0 + h) * 128 + dc * 8), b = *(const u32x4*)(zr + (4 + h) * 128 + dc * 8), c = *(const u32x4*)(zr + (8 + h) * 128 + dc * 8);
        const u32x4 ga = *(const u32x4*)(zr + C_GA + h * 128 + dc * 8);
        u32x4 o;
#define CMB(f) o.f = cvt_pk_bf16((e0 * bf_lo(a.f) + e1 * bf_lo(b.f) + e2 * bf_lo(c.f)) * silu(bf_lo(ga.f)), (e0 * bf_hi(a.f) + e1 * bf_hi(b.f) + e2 * bf_hi(c.f)) * silu(bf_hi(ga.f)))
        CMB(x); CMB(y); CMB(z); CMB(w);
#undef CMB
        *(u32x4*)(zr + C_GA + h * 128 + dc * 8) = o;
    }
}

constexpr int XCF_STRIDE = 132, LDS_XCF = 0, LDS_XCB = 64 * XCF_STRIDE * 4, LDS_CW = LDS_XCB + 64 * KVS, LDS_RAW = 54272, RAW_BYTES = 68 * 256;
static_assert(LDS_CW + 5 * 128 * 4 <= LDS_RAW && LDS_RAW + 2 * RAW_BYTES <= 131072, "LRU LDS map");
__device__ __forceinline__ float sigm2(float x) { return __builtin_amdgcn_rcpf(1.0f + __builtin_amdgcn_exp2f(x * -LOG2E)); }
template <int PASS>
__device__ __forceinline__ void lru_phase(LAS unsigned char* lds, bf16_t* Z, int S, const float* convw, const float* convb, const bf16_t* LWt, const float* lrub, const float* lam,
                                          f32x2* __restrict__ AGG, const float* __restrict__ CARRY, int bid, int G) {
    int tid = threadIdx.x; asm volatile("" : "+v"(tid));
    const int lane = tid & 63, w = __builtin_amdgcn_readfirstlane(tid >> 6), l15 = lane & 15, quad = lane >> 4;
    LAS float* xcf = (LAS float*)(lds + LDS_XCF);
    LAS float* cw = (LAS float*)(lds + LDS_CW);
    const int nb16 = G >> 4, n = bid & 15, cfirst = bid >> 4, NC = S >> 6;
    if (cfirst >= nb16) return;
    const int chl = 16 * w + l15, ch = n * 128 + chl;
    for (int i = tid; i < 5 * 128; i += 512) { const int j = i >> 7, ci = i & 127; cw[i] = (j < 4) ? convw[j * DM + n * 128 + ci] : convb[n * 128 + ci]; }
    bf16x8 bw[2][2][4]; float br[2], bi[2], k8[2];
#pragma unroll
    for (int dir = 0; dir < 2; ++dir) {
#pragma unroll
        for (int gt = 0; gt < 2; ++gt)
#pragma unroll
            for (int ks = 0; ks < 4; ++ks) bw[dir][gt][ks] = *(const bf16x8*)(LWt + ((size_t)(((dir * 2 + gt) * 16 + n) * 128 + chl)) * 128 + ks * 32 + quad * 8);
        br[dir] = lrub[((dir * 2 + 0) * 16 + n) * 128 + chl]; bi[dir] = lrub[((dir * 2 + 1) * 16 + n) * 128 + chl];
        k8[dir] = -8.0f * LOG2E * log1pf(__expf(-lam[dir * DM + ch]));
    }
    __syncthreads();
#define LRU_DMA(cx, buf) do { _Pragma("unroll") for (int q_ = 0; q_ < 3; ++q_) { const int q = w + 8 * q_; if (q < 17) { const int idx = q * 64 + lane, rr = idx >> 4, cc_ = idx & 15; \
        int t_ = (cx) * 64 + rr - 2; t_ = t_ < 0 ? 0 : (t_ >= S ? S - 1 : t_); \
        __builtin_amdgcn_global_load_lds((const unsigned*)(Z + (size_t)t_ * NIN + C_XR + n * 128 + cc_ * 8), (LAS unsigned*)(lds + LDS_RAW + (buf) * RAW_BYTES + q * 1024), 16, 0, 0); } } } while (0)
    int buf = 0;
    if (cfirst < NC) LRU_DMA(cfirst, 0);
    for (int c = cfirst; c < NC; c += nb16) {
        const int t0 = c * 64;
        asm volatile("s_waitcnt vmcnt(0)" ::: "memory");
        LBAR();
        const LAS unsigned char* raw = lds + LDS_RAW + buf * RAW_BYTES;
#pragma unroll
        for (int k = 0; k < 2; ++k) { const int item = tid + 512 * k, tt = item >> 4, cc = item & 15;
            f32x4 x0 = *(const LAS f32x4*)(cw + 4 * 128 + cc * 8), x1 = *(const LAS f32x4*)(cw + 4 * 128 + cc * 8 + 4);
#pragma unroll
            for (int j = 0; j < 4; ++j) { const int row = t0 + tt + j - 2;
                if (row >= 0 && row < S) { const u32x4 x = *(const LAS u32x4*)(raw + (tt + j) * 256 + cc * 16);
                    const f32x4 w0 = *(const LAS f32x4*)(cw + j * 128 + cc * 8), w1 = *(const LAS f32x4*)(cw + j * 128 + cc * 8 + 4);
                    x0[0] += bf_lo(x.x) * w0[0]; x0[1] += bf_hi(x.x) * w0[1]; x0[2] += bf_lo(x.y) * w0[2]; x0[3] += bf_hi(x.y) * w0[3];
                    x1[0] += bf_lo(x.z) * w1[0]; x1[1] += bf_hi(x.z) * w1[1]; x1[2] += bf_lo(x.w) * w1[2]; x1[3] += bf_hi(x.w) * w1[3]; } }
            *(LAS f32x4*)(xcf + tt * XCF_STRIDE + cc * 8) = x0; *(LAS f32x4*)(xcf + tt * XCF_STRIDE + cc * 8 + 4) = x1;
            u32x4 pk; pk.x = cvt_pk_bf16(x0[0], x0[1]); pk.y = cvt_pk_bf16(x0[2], x0[3]); pk.z = cvt_pk_bf16(x1[0], x1[1]); pk.w = cvt_pk_bf16(x1[2], x1[3]);
            *(LAS u32x4*)(lds + LDS_XCB + (16 * ((tt >> 2) & 3) + 4 * (tt >> 4) + (tt & 3)) * KVS + cc * 16) = pk; }
        LBAR();
        buf ^= 1;
        if (c + nb16 < NC) LRU_DMA(c + nb16, buf);
        u32x4 gpre[2]; float hpre[2] = {0.f, 0.f};
        if (PASS == 1) {
#pragma unroll
            for (int k = 0; k < 2; ++k) { const int item = tid + 512 * k, tt = item >> 4, cc = item & 15; gpre[k] = *(const u32x4*)(Z + (size_t)(t0 + tt) * NIN + C_GR + n * 128 + cc * 8); }
            hpre[0] = CARRY[(size_t)(c * 2 + 0) * DM + ch]; hpre[1] = CARRY[(size_t)(c * 2 + 1) * DM + ch];
        }
        float hsum[4][4];
#pragma unroll
        for (int dir = 0; dir < 2; ++dir) {
            f32x4 ga[2][4];
#pragma unroll
            for (int mt = 0; mt < 4; ++mt) { ga[0][mt] = (f32x4){0.f, 0.f, 0.f, 0.f}; ga[1][mt] = (f32x4){0.f, 0.f, 0.f, 0.f};
#pragma unroll
                for (int ks = 0; ks < 4; ++ks) { const bf16x8 a = *(const LAS bf16x8*)(lds + LDS_XCB + (16 * mt + l15) * KVS + ks * 64 + quad * 16);
                    ga[0][mt] = __builtin_amdgcn_mfma_f32_16x16x32_bf16(a, bw[dir][0][ks], ga[0][mt], 0, 0, 0);
                    ga[1][mt] = __builtin_amdgcn_mfma_f32_16x16x32_bf16(a, bw[dir][1][ks], ga[1][mt], 0, 0, 0); } }
            float av[4][4], bv[4][4];
#pragma unroll
            for (int mt = 0; mt < 4; ++mt)
#pragma unroll
                for (int i = 0; i < 4; ++i) { const float rg = sigm2(ga[0][mt][i] + br[dir]), ig = sigm2(ga[1][mt][i] + bi[dir]);
                    const float xcv = xcf[(16 * quad + 4 * mt + i) * XCF_STRIDE + chl];
                    const float av_ = __builtin_amdgcn_exp2f(k8[dir] * rg);
                    av[mt][i] = av_; bv[mt][i] = __builtin_amdgcn_sqrtf(fmaxf(1.0f - av_ * av_, 0.f)) * (ig * xcv); }
            float H = 0.f, Ptot = 1.f;
            if (PASS == 1) H = hpre[dir];
            if (dir == 0) {
                float As = 1.f, Bs = 0.f;
#pragma unroll
                for (int mt = 0; mt < 4; ++mt)
#pragma unroll
                    for (int i = 0; i < 4; ++i) { Bs = av[mt][i] * Bs + bv[mt][i]; As *= av[mt][i]; }
                float Ap = __shfl_up(As, 16), Bp = __shfl_up(Bs, 16); if (quad >= 1) { Bs = As * Bp + Bs; As = Ap * As; }
                Ap = __shfl_up(As, 32); Bp = __shfl_up(Bs, 32); if (quad >= 2) { Bs = As * Bp + Bs; As = Ap * As; }
                float Ae = __shfl_up(As, 16), Be = __shfl_up(Bs, 16); if (quad == 0) { Ae = 1.f; Be = 0.f; }
                const float At = __shfl(As, 48 + l15), Bt = __shfl(Bs, 48 + l15);
                float h = Ae * H + Be; H = At * H + Bt; Ptot = At;
#pragma unroll
                for (int mt = 0; mt < 4; ++mt)
#pragma unroll
                    for (int i = 0; i < 4; ++i) { h = av[mt][i] * h + bv[mt][i]; hsum[mt][i] = h; }
            } else {
                float As = 1.f, Bs = 0.f;
#pragma unroll
                for (int mt = 3; mt >= 0; --mt)
#pragma unroll
                    for (int i = 3; i >= 0; --i) { Bs = av[mt][i] * Bs + bv[mt][i]; As *= av[mt][i]; }
                float Ap = __shfl_down(As, 16), Bp = __shfl_down(Bs, 16); if (quad <= 2) { Bs = As * Bp + Bs; As = Ap * As; }
                Ap = __shfl_down(As, 32); Bp = __shfl_down(Bs, 32); if (quad <= 1) { Bs = As * Bp + Bs; As = Ap * As; }
                float Ae = __shfl_down(As, 16), Be = __shfl_down(Bs, 16); if (quad == 3) { Ae = 1.f; Be = 0.f; }
                const float At = __shfl(As, l15), Bt = __shfl(Bs, l15);
                float h = Ae * H + Be; H = At * H + Bt; Ptot = At;
#pragma unroll
                for (int mt = 3; mt >= 0; --mt)
#pragma unroll
                    for (int i = 3; i >= 0; --i) { h = av[mt][i] * h + bv[mt][i]; hsum[mt][i] += h; }
            }
            if (PASS == 0) { if (quad == 0) AGG[(size_t)(c * 2 + dir) * DM + ch] = (f32x2){Ptot, H}; }
        }
        if (PASS == 1) {
            LBAR();
#pragma unroll
            for (int mt = 0; mt < 4; ++mt)
#pragma unroll
                for (int i = 0; i < 4; ++i) xcf[(16 * quad + 4 * mt + i) * XCF_STRIDE + chl] = hsum[mt][i];
            LBAR();
#pragma unroll
            for (int k = 0; k < 2; ++k) { const int item = tid + 512 * k, tt = item >> 4, cc = item & 15;
                const f32x4 h0 = *(const LAS f32x4*)(xcf + tt * XCF_STRIDE + cc * 8), h1 = *(const LAS f32x4*)(xcf + tt * XCF_STRIDE + cc * 8 + 4);
                bf16_t* p = Z + (size_t)(t0 + tt) * NIN + C_GR + n * 128 + cc * 8;
                const u32x4 g = gpre[k];
                u32x4 o; o.x = cvt_pk_bf16(h0[0] * silu(bf_lo(g.x)), h0[1] * silu(bf_hi(g.x))); o.y = cvt_pk_bf16(h0[2] * silu(bf_lo(g.y)), h0[3] * silu(bf_hi(g.y)));
                o.z = cvt_pk_bf16(h1[0] * silu(bf_lo(g.z)), h1[1] * silu(bf_hi(g.z))); o.w = cvt_pk_bf16(h1[2] * silu(bf_lo(g.w)), h1[3] * silu(bf_hi(g.w)));
                *(u32x4*)p = o; }
        }
        LBAR();
    }
}

__device__ __forceinline__ void carry_phase(LAS unsigned char* lds, const f32x2* __restrict__ AGG, float* __restrict__ CARRY, int S, int bid, int G) {
    int tid = threadIdx.x; asm volatile("" : "+v"(tid));
    const int NC = S >> 6, SEG = NC >> 4, seg = tid >> 5, cl = tid & 31;
    LAS f32x2* sagg = (LAS f32x2*)lds;
    for (int cb = bid; cb < (2 * DM) / 32; cb += G) {
        const int chain = cb * 32 + cl, dir = chain >> 11, ch = chain & (DM - 1);
        float Ae[16], Be[16]; float A = 1.f, B = 0.f;
#pragma unroll
        for (int k = 0; k < 16; ++k) { Ae[k] = A; Be[k] = B;
            if (k < SEG) { const int p = seg * SEG + k, c = dir ? (NC - 1 - p) : p; const f32x2 ab = AGG[(size_t)(c * 2 + dir) * DM + ch]; B = ab.x * B + ab.y; A = ab.x * A; } }
        sagg[seg * 32 + cl] = (f32x2){A, B};
        __syncthreads();
        float h = 0.f;
        for (int s2 = 0; s2 < seg; ++s2) { const f32x2 ab = sagg[s2 * 32 + cl]; h = ab.x * h + ab.y; }
#pragma unroll
        for (int k = 0; k < 16; ++k) if (k < SEG) { const int p = seg * SEG + k, c = dir ? (NC - 1 - p) : p; CARRY[(size_t)(c * 2 + dir) * DM + ch] = Ae[k] * h + Be[k]; }
        __syncthreads();
    }
}

__device__ __forceinline__ void ln_phase(float* io, bf16_t* xb, int S, const float* lng, const float* lnb, int bid, int G) {
    int tid = threadIdx.x; asm volatile("" : "+v"(tid));
    const int lane = tid & 63, gw = bid * 8 + (tid >> 6), NGW = G * 8;
    f32x4 gv[8], bv[8];
#pragma unroll
    for (int j = 0; j < 8; ++j) { gv[j] = ((const f32x4*)lng)[lane + 64 * j]; bv[j] = ((const f32x4*)lnb)[lane + 64 * j]; }
    for (int row = gw; row < S; row += NGW) {
        f32x4* p = (f32x4*)(io + (size_t)row * DM);
        f32x4 v[8]; float s = 0.f;
#pragma unroll
        for (int j = 0; j < 8; ++j) { v[j] = p[lane + 64 * j]; s += (v[j][0] + v[j][1]) + (v[j][2] + v[j][3]); }
#pragma unroll
        for (int o = 1; o < 64; o <<= 1) s += __shfl_xor(s, o);
        const float mean = s * (1.0f / DM); float q = 0.f;
#pragma unroll
        for (int j = 0; j < 8; ++j) { v[j] = v[j] - mean; q += (v[j][0] * v[j][0] + v[j][1] * v[j][1]) + (v[j][2] * v[j][2] + v[j][3] * v[j][3]); }
#pragma unroll
        for (int o = 1; o < 64; o <<= 1) q += __shfl_xor(q, o);
        const float rstd = 1.0f / sqrtf(q * (1.0f / DM) + LN_EPS);
#pragma unroll
        for (int j = 0; j < 8; ++j) { const f32x4 y = v[j] * rstd * gv[j] + bv[j]; p[lane + 64 * j] = y;
            if (xb) { u32x2 o2; o2.x = cvt_pk_bf16(y[0], y[1]); o2.y = cvt_pk_bf16(y[2], y[3]); ((u32x2*)(xb + (size_t)row * DM))[lane + 64 * j] = o2; } }
    }
}


#define XB_TMO      128
#define XB_XCNT(j)  (256  + 64 * (j))
#define XB_XSUB(j)  (1280 + 64 * (j))
#define XB_XGEN(j)  (2304 + 64 * (j))
#define XB_TOP      3328
#define XB_TOPGEN   3392
#define XCD_BAR_WORDS 3456
#define XB_SPIN_CAP (1u << 22)
__device__ __forceinline__ unsigned xb_ld(unsigned* p)              { return __hip_atomic_load(p, __ATOMIC_RELAXED, __HIP_MEMORY_SCOPE_AGENT); }
__device__ __forceinline__ unsigned xb_add(unsigned* p, unsigned v) { return __hip_atomic_fetch_add(p, v, __ATOMIC_RELAXED, __HIP_MEMORY_SCOPE_AGENT); }
__device__ __forceinline__ unsigned xb_xcc_id() { return (unsigned)__builtin_amdgcn_s_getreg((3 << 11) | 20) & 0xFu; }
#define XB_SPIN(cond, bar) do { unsigned _sp = 0; while (cond) { __builtin_amdgcn_s_sleep(1); \
    if ((++_sp & 255u) == 0u) { if (xb_ld(&(bar)[XB_TMO])) break; if (_sp > XB_SPIN_CAP) { atomicAdd(&(bar)[XB_TMO], 1u); break; } } } } while (0)
struct XcdBarrier { unsigned* bar; unsigned x; volatile LAS unsigned* st; };
__device__ __forceinline__ XcdBarrier xcd_barrier_post(unsigned* bar, volatile LAS unsigned* st) {
    XcdBarrier b; b.bar = bar; b.x = xb_xcc_id(); b.st = st;
    if (threadIdx.x == 0) (void)xb_add(&bar[XB_XCNT(b.x)], 1u);
    return b;
}
__device__ __forceinline__ void xcd_barrier_complete(unsigned* bar, unsigned x, unsigned& nloc, unsigned& nx) {
    const unsigned G = gridDim.x * gridDim.y * gridDim.z;
    unsigned sum, cnt, mine, sp = 0u;
    for (;;) {
        sum = 0u; cnt = 0u; mine = 0u;
#pragma unroll
        for (unsigned j = 0; j < 16; ++j) { const unsigned c = xb_ld(&bar[XB_XCNT(j)]); sum += c; cnt += (c > 0u) ? 1u : 0u; mine = (j == x) ? c : mine; }
        if (sum == G) break;
        __builtin_amdgcn_s_sleep(1);
        if ((++sp & 255u) == 0u) { if (xb_ld(&bar[XB_TMO])) break; if (sp > XB_SPIN_CAP) { atomicAdd(&bar[XB_TMO], 1u); break; } }
    }
    nloc = mine > 0u ? mine : 1u; nx = cnt > 0u ? cnt : 1u;
}
__device__ __forceinline__ void xcd_barrier(const XcdBarrier& b) {
    asm volatile("s_waitcnt vmcnt(0)" ::: "memory");
    __syncthreads();
    if (threadIdx.x == 0) {
        unsigned* bar = b.bar;
        __builtin_amdgcn_s_waitcnt(0);
        unsigned nloc = b.st[0], nx = b.st[1];
        if (nloc == 0u) { xcd_barrier_complete(bar, b.x, nloc, nx); b.st[0] = nloc; b.st[1] = nx; }
        const unsigned old = xb_add(&bar[XB_XSUB(b.x)], 1u);
        const unsigned gen = old / nloc;
        if (old + 1u == (gen + 1u) * nloc) {
            __builtin_amdgcn_fence(__ATOMIC_RELEASE, "agent");
            asm volatile("s_waitcnt vmcnt(0)" ::: "memory");
            const unsigned og = xb_add(&bar[XB_TOP], 1u);
            const unsigned tg = og / nx;
            if (og + 1u == (tg + 1u) * nx) xb_add(&bar[XB_TOPGEN], 1u);
            else XB_SPIN(xb_ld(&bar[XB_TOPGEN]) == tg, bar);
            __builtin_amdgcn_fence(__ATOMIC_ACQUIRE, "agent");
            xb_add(&bar[XB_XGEN(b.x)], 1u);
            asm volatile("s_waitcnt vmcnt(0)" ::: "memory");
        } else {
            XB_SPIN(xb_ld(&bar[XB_XGEN(b.x)]) == gen, bar);
            __builtin_amdgcn_fence(__ATOMIC_ACQUIRE, "agent");
            asm volatile("s_waitcnt vmcnt(0)" ::: "memory");
        }
    }
    __syncthreads();
}

struct Args { const float* in[15]; float* out; unsigned char* ws; };

__global__ void __launch_bounds__(512, 2) fwd_kernel(Args a) {
    extern __shared__ __attribute__((aligned(16))) unsigned char lds_raw[];
    LAS unsigned char* lds = (LAS unsigned char*)lds_raw;
    cg::grid_group grid = cg::this_grid();
    const int tid = threadIdx.x, lane = tid & 63, wave = __builtin_amdgcn_readfirstlane(tid >> 6);
    const int G = gridDim.x, bid = blockIdx.x;
    const int gw = bid * 8 + wave, NGW = G * 8;
    unsigned char* ws = a.ws;
    float* biasTab = (float*)(ws + WS_BIAS);
    bf16_t* WIN = (bf16_t*)(ws + WS_WIN); bf16_t* WA = (bf16_t*)(ws + WS_WA); bf16_t* WR = (bf16_t*)(ws + WS_WR); bf16_t* WO = (bf16_t*)(ws + WS_WO); bf16_t* LW = (bf16_t*)(ws + WS_LW);
    bf16_t* XB = (bf16_t*)(ws + WS_XB); bf16_t* Z = (bf16_t*)(ws + WS_Z);
    float* LSE = (float*)(ws + WS_LSE); f32x2* AGG = (f32x2*)(ws + WS_AGG); float* CARRY = (float*)(ws + WS_CARRY);

    unsigned* barw = (unsigned*)ws;
    volatile LAS unsigned* bst = (volatile LAS unsigned*)(lds + LDS_BYTES - 64);
    if (bid == 0) { for (int i = tid; i < XCD_BAR_WORDS; i += 512) __hip_atomic_store(barw + i, 0u, __ATOMIC_RELAXED, __HIP_MEMORY_SCOPE_AGENT); }
    if (tid == 0) { bst[0] = 0u; bst[1] = 0u; }
    {
        LAS float* scr = (LAS float*)(lds + wave * 16384);
        constexpr int I_IN = (DM / 64) * (NIN / 32), I_A = (512 / 64) * (DM / 32), I_R = (DM / 64) * (DM / 32), I_L = 2 * 4;
        constexpr int NITEMS = 2 * I_IN + 2 * I_A + 4 * I_R + 128 * I_L;
        for (int it = gw; it < NITEMS; it += NGW) {
            int r = it;
            if (r < 2 * I_IN) { const int l = r / I_IN; p0_transpose_item(a.in[2] + (size_t)l * DM * NIN, DM, NIN, WIN + (size_t)l * NIN * DM, scr, r % I_IN, lane); continue; } r -= 2 * I_IN;
            if (r < 2 * I_A) { const int l = r / I_A; p0_transpose_item(a.in[9] + (size_t)l * 512 * DM, 512, DM, WA + (size_t)l * DM * 512, scr, r % I_A, lane); continue; } r -= 2 * I_A;
            if (r < 2 * I_R) { const int l = r / I_R; p0_transpose_item(a.in[10] + (size_t)l * DM * DM, DM, DM, WR + (size_t)l * DM * DM, scr, r % I_R, lane); continue; } r -= 2 * I_R;
            if (r < 2 * I_R) { const int l = r / I_R; p0_transpose_item(a.in[11] + (size_t)l * DM * DM, DM, DM, WO + (size_t)l * DM * DM, scr, r % I_R, lane); continue; } r -= 2 * I_R;
            { const int mtx = r / I_L; p0_transpose_item(a.in[6] + (size_t)mtx * 16384, 128, 128, LW + (size_t)mtx * 16384, scr, r % I_L, lane); }
        }
        const int gt = bid * 512 + tid, GT = G * 512;
        for (int i = gt; i < NTOK * (DM / 8); i += GT) {
            const size_t e = (size_t)i * 8; const float* src = (e < (size_t)8192 * DM) ? (a.in[0] + e) : (a.in[1] + (e - (size_t)8192 * DM));
            const f32x4 x0 = *(const f32x4*)src, x1 = *(const f32x4*)(src + 4);
            u32x4 o; o.x = cvt_pk_bf16(x0[0], x0[1]); o.y = cvt_pk_bf16(x0[2], x0[3]); o.z = cvt_pk_bf16(x1[0], x1[1]); o.w = cvt_pk_bf16(x1[2], x1[3]);
            *(u32x4*)(XB + e) = o;
        }
        for (int i = gt; i < 12 * 129; i += GT) { const int hd = i / 129, k = i % 129; biasTab[i] = a.in[14][(int)T5B[hd >> 2][k] * 12 + hd] * LOG2E; }
    }
    __threadfence();
    grid.sync();
    const XcdBarrier xbar = xcd_barrier_post(barw, bst);

#pragma nounroll
    for (int step = 0; step < 4; ++step) {
        const int l = step >> 1, bb = step & 1;
        const int SR = bb ? 16384 : 24576, rowoff = bb ? 24576 : 0, nseq = bb ? 1 : 2;
        float* outb = a.out + (size_t)rowoff * DM;
        const float* convw = a.in[4] + (size_t)l * 4 * DM; const float* convb = a.in[5] + (size_t)l * DM; const bf16_t* LWl = LW + (size_t)l * 64 * 16384;
        const float* lrub = a.in[7] + (size_t)l * 64 * 128; const float* lam = a.in[8] + (size_t)l * 2 * DM;
        { pg8::Gemm g{XB + (size_t)rowoff * DM, WIN + (size_t)l * NIN * DM, SR, NIN, DM, DM}; pg8::StaticOrder so; so.init(SR, NIN, G, bid);
          pg8::EpiIn E{Z, NIN, a.in[3] + (size_t)l * NIN}; pg8::gemm_phase<pg8::EpiIn>(lds, g, so, E); }
        xcd_barrier(xbar);
#pragma nounroll
        for (int sq = 0; sq < nseq; ++sq) { const int so_ = (sq == 0) ? 0 : 8192, S = (bb == 0 && sq == 0) ? 8192 : 16384;
            attn_phase(lds, Z + (size_t)so_ * NIN, S, LSE + (size_t)so_ * 12, biasTab, bid, G); }
#pragma nounroll
        for (int sq = 0; sq < nseq; ++sq) { const int so_ = (sq == 0) ? 0 : 8192, S = (bb == 0 && sq == 0) ? 8192 : 16384;
            lru_phase<0>(lds, Z + (size_t)so_ * NIN, S, convw, convb, LWl, lrub, lam, AGG + (size_t)(so_ >> 6) * 2 * DM, CARRY + (size_t)(so_ >> 6) * 2 * DM, bid, G); }
        xcd_barrier(xbar);
#pragma nounroll
        for (int sq = 0; sq < nseq; ++sq) { const int so_ = (sq == 0) ? 0 : 8192, S = (bb == 0 && sq == 0) ? 8192 : 16384;
            carry_phase(lds, AGG + (size_t)(so_ >> 6) * 2 * DM, CARRY + (size_t)(so_ >> 6) * 2 * DM, S, (bid + 128 * sq) % G, G); }
        xcd_barrier(xbar);
#pragma nounroll
        for (int sq = 0; sq < nseq; ++sq) { const int so_ = (sq == 0) ? 0 : 8192, S = (bb == 0 && sq == 0) ? 8192 : 16384;
            lru_phase<1>(lds, Z + (size_t)so_ * NIN, S, convw, convb, LWl, lrub, lam, AGG + (size_t)(so_ >> 6) * 2 * DM, CARRY + (size_t)(so_ >> 6) * 2 * DM, bid, G); }
        combine_phase(Z, SR, LSE, bid, G);
        xcd_barrier(xbar);
        { pg8::Gemm g{Z + C_GA, WA + (size_t)l * DM * 512, SR, DM, 512, NIN}; pg8::StaticOrder so; so.init(SR, DM, G, bid);
          pg8::EpiGateA E{Z}; pg8::gemm_phase<pg8::EpiGateA>(lds, g, so, E); }
        { pg8::Gemm g{Z + C_GR, WR + (size_t)l * DM * DM, SR, DM, DM, NIN}; pg8::StaticOrder so; so.init(SR, DM, G, bid);
          pg8::EpiGateR E{Z}; pg8::gemm_phase<pg8::EpiGateR>(lds, g, so, E); }
        xcd_barrier(xbar);
        { const float* xA = (l == 0) ? (bb ? a.in[1] + (size_t)16384 * DM : a.in[0]) : outb;
          const float* xB = (l == 0) ? a.in[1] : outb + (size_t)8192 * DM;
          const int split = bb ? SR : 8192;
          pg8::Gemm g{Z + C_M, WO + (size_t)l * DM * DM, SR, DM, DM, NIN}; pg8::StaticOrder so; so.init(SR, DM, G, bid);
          pg8::EpiRes E{xA, xB, split, outb}; pg8::gemm_phase<pg8::EpiRes>(lds, g, so, E); }
        xcd_barrier(xbar);
        ln_phase(outb, (l == 0) ? (XB + (size_t)rowoff * DM) : (bf16_t*)nullptr, SR, a.in[12] + (size_t)l * DM, a.in[13] + (size_t)l * DM, bid, G);
    }
}

extern "C" void kernel_launch(void* const* d_in, const int* in_sizes, int n_in, void* d_out, int out_size, void* d_ws, size_t ws_size, hipStream_t stream) {
    static int grid = 0;
    if (grid == 0) {
        if (n_in != 15 || out_size != NTOK * DM || ws_size < WS_END) { fprintf(stderr, "kernel_launch: unexpected shapes (n_in %d out %d ws %zu)\n", n_in, out_size, ws_size); grid = -1; return; }
        int dev = 0, cus = 0, per_cu = 0;
        (void)hipGetDevice(&dev);
        (void)hipDeviceGetAttribute(&cus, hipDeviceAttributeMultiprocessorCount, dev);
        (void)hipFuncSetAttribute((const void*)fwd_kernel, hipFuncAttributeMaxDynamicSharedMemorySize, LDS_BYTES);
        (void)hipOccupancyMaxActiveBlocksPerMultiprocessor(&per_cu, (const void*)fwd_kernel, 512, LDS_BYTES);
        if (per_cu < 1) per_cu = 1;
        grid = cus * per_cu;
    }
    if (grid < 0) return;
    Args a{};
    for (int i = 0; i < 15; ++i) a.in[i] = (const float*)d_in[i];
    a.out = (float*)d_out; a.ws = (unsigned char*)d_ws;
    void* args[] = {&a};
    hipError_t e = hipLaunchCooperativeKernel((const void*)fwd_kernel, dim3(grid), dim3(512), args, LDS_BYTES, stream);
    if (e != hipSuccess) fprintf(stderr, "cooperative launch failed: %s (grid %d)\n", hipGetErrorString(e), grid);
}
```
